# Optimizing an MI355X kernel written in HIP

```python
import jax, jax.numpy as jnp
from jax import lax
import numpy as np

D_MODEL = 1024
BATCH = 4
SEQ = 8192
DEPTH = 2

N_EVEN = (DEPTH + 1) // 2
N_ODD = DEPTH // 2

DN_ALPHA = (2.0 * DEPTH) ** 0.25
DN_BETA = (8.0 * DEPTH) ** -0.25
LN_EPS = 1e-5

D_FF = 2816
FFN_RES = 0.5

CONV_DIM = D_MODEL // 2
CONV_WIDTH = 31
SB_HEADS = 8
SB_HEAD_DIM = 64
SB_DIM = SB_HEADS * SB_HEAD_DIM
Q_BLOCK = 128
IN0_DIM = 2 * CONV_DIM + 3 * SB_DIM
MIX0_DIM = CONV_DIM + SB_DIM

RW_HEADS = 8
RW_HEAD_DIM = 64
RW_DIM = RW_HEADS * RW_HEAD_DIM
DECAY_LORA = 64
ICLR_LORA = 64
GATE_LORA = 128
RW_IN_DIM = 3 * RW_DIM + DECAY_LORA + ICLR_LORA + GATE_LORA
RW_SPLITS = (RW_DIM, 2 * RW_DIM, 3 * RW_DIM, 3 * RW_DIM + DECAY_LORA, 3 * RW_DIM + DECAY_LORA + ICLR_LORA)
GN_EPS = RW_HEAD_DIM * 1e-5
POOL_WINDOWS = (2, 4, 8, 16)
POOL_GROUPS = 4
POOL_GROUP_DIM = 128
POOL_DIM = POOL_GROUPS * POOL_GROUP_DIM
IN1_DIM = RW_IN_DIM + POOL_DIM
MIX1_DIM = RW_DIM + POOL_DIM

kernel_name = "hybrid_conv_stickbreak_rwkv7_pool_deepnorm"


def layer_norm(x, g, b, eps=LN_EPS):
    xf = x.astype(jnp.float32)
    mu = jnp.mean(xf, axis=-1, keepdims=True)
    var = jnp.mean(jnp.square(xf - mu), axis=-1, keepdims=True)
    y = (xf - mu) * lax.rsqrt(var + eps)
    return (y * g.astype(jnp.float32) + b.astype(jnp.float32)).astype(x.dtype)


def swiglu(x, w_in, w_out):
    gate, up = jnp.split(x @ w_in, 2, axis=-1)
    return (jax.nn.silu(gate) * up) @ w_out


def conformer_conv(u, w_dw, b_dw, g, b):
    a, gate = jnp.split(u, 2, axis=-1)
    h = a * jax.nn.sigmoid(gate)
    h = lax.conv_general_dilated(h, w_dw[:, None, :], window_strides=(1,),
                                 padding=[(CONV_WIDTH - 1, 0)],
                                 dimension_numbers=('NWC', 'WIO', 'NWC'),
                                 feature_group_count=CONV_DIM) + b_dw
    return jax.nn.silu(layer_norm(h, g, b))


def stick_breaking_attention(q, k, v):
    seq = q.shape[2]
    scale = SB_HEAD_DIM ** -0.5
    outs = []
    for blk in range(seq // Q_BLOCK):
        start = blk * Q_BLOCK
        end = start + Q_BLOCK
        z = jnp.einsum('bhqd,bhkd->bhqk', q[:, :, start:end], k[:, :, :end],
                       preferred_element_type=jnp.float32) * scale
        mask = jnp.arange(end)[None, :] < jnp.arange(start, end)[:, None]
        log_keep = jnp.where(mask, jax.nn.log_sigmoid(-z), 0.0)
        log_tail = lax.cumsum(log_keep, axis=3, reverse=True) - log_keep
        att = jnp.where(mask, jnp.exp(jax.nn.log_sigmoid(z) + log_tail), 0.0)
        outs.append(jnp.einsum('bhqk,bhkd->bhqd', att.astype(v.dtype), v[:, :, :end]))
    return jnp.concatenate(outs, axis=2)


def even_mixer(x, w_in, w_dw, b_dw, conv_g, conv_b, w_out):
    bsz, seq, _ = x.shape
    h = x @ w_in
    y_conv = conformer_conv(h[..., :2 * CONV_DIM], w_dw, b_dw, conv_g, conv_b)
    qkv = h[..., 2 * CONV_DIM:].reshape(bsz, seq, 3, SB_HEADS, SB_HEAD_DIM)
    qkv = jnp.transpose(qkv, (2, 0, 3, 1, 4))
    y_att = stick_breaking_attention(qkv[0], qkv[1], qkv[2])
    y_att = jnp.transpose(y_att, (0, 2, 1, 3)).reshape(bsz, seq, SB_DIM)
    return jnp.concatenate([y_conv, y_att], axis=-1) @ w_out


def token_shift(p, mu):
    p_prev = jnp.pad(p, ((0, 0), (1, 0), (0, 0)))[:, :-1]
    return p + (p_prev - p) * mu


def rwkv7_recurrence(r, w, k, v, a, b):
    bsz, seq, nh, nd = r.shape

    def step(state, inp):
        r_t, w_t, k_t, v_t, a_t, b_t = inp
        sa = jnp.einsum('bhij,bhj->bhi', state, a_t)
        state = (state * w_t[:, :, None, :] + sa[..., :, None] * b_t[..., None, :]
                 + v_t[..., :, None] * k_t[..., None, :])
        return state, jnp.einsum('bhij,bhj->bhi', state, r_t)

    xs = (jnp.moveaxis(r, 1, 0), jnp.moveaxis(w, 1, 0), jnp.moveaxis(k, 1, 0),
          jnp.moveaxis(v, 1, 0), jnp.moveaxis(a, 1, 0), jnp.moveaxis(b, 1, 0))
    state0 = jnp.zeros((bsz, nh, nd, nd), jnp.float32)
    _, y = lax.scan(step, state0, xs)
    return jnp.moveaxis(y, 0, 1)


def rwkv7_time_mix(p, mu, w0, w2, a0, a2, g2, k_k, k_a, r_k, lnx_g, lnx_b):
    bsz, seq, _ = p.shape
    f32 = jnp.float32
    p = token_shift(p, mu)
    r, k, v, w_lr, a_lr, g_lr = jnp.split(p, RW_SPLITS, axis=-1)
    log_w = -jax.nn.softplus(-(w0 + jnp.tanh(w_lr) @ w2).astype(f32)) - 0.5
    decay = jnp.exp(-jnp.exp(log_w))
    iclr = jax.nn.sigmoid((a0 + a_lr @ a2).astype(f32))
    gate = (jax.nn.sigmoid(g_lr) @ g2).astype(f32)

    def heads(t):
        return t.astype(f32).reshape(bsz, seq, RW_HEADS, RW_HEAD_DIM)

    r_h, k_h, v_h, w_h, a_h = heads(r), heads(k), heads(v), heads(decay), heads(iclr)
    kk = k_h * k_k.astype(f32)
    kk = kk * lax.rsqrt(jnp.maximum(jnp.sum(kk * kk, axis=-1, keepdims=True), 1e-24))
    k_h = k_h * (1.0 + (a_h - 1.0) * k_a.astype(f32))
    y = rwkv7_recurrence(r_h, w_h, k_h, v_h, -kk, kk * a_h)
    y = layer_norm(y, lnx_g, lnx_b, GN_EPS)
    y = y + jnp.sum(r_h * k_h * r_k.astype(f32), axis=-1, keepdims=True) * v_h
    return (y.reshape(bsz, seq, RW_DIM) * gate).astype(p.dtype)


def multiscale_pool(u, w_pool, b_pool, scale):
    bsz, seq, _ = u.shape
    ug = u.astype(jnp.float32).reshape(bsz, seq, POOL_GROUPS, POOL_GROUP_DIM)
    csum = jnp.pad(jnp.cumsum(ug, axis=1), ((0, 0), (1, 0), (0, 0), (0, 0)))
    t = jnp.arange(seq)
    outs = []
    for gi, win in enumerate(POOL_WINDOWS):
        c = csum[:, :, gi]
        lo = jnp.pad(c, ((0, 0), (win - 1, 0), (0, 0)))[:, :seq]
        count = jnp.minimum(t + 1, win).astype(jnp.float32)[None, :, None]
        outs.append((c[:, 1:] - lo) / count)
    pooled = (jnp.stack(outs, axis=2) - ug).astype(u.dtype)
    y = jnp.einsum('bsgc,gcd->bsgd', pooled, w_pool) + b_pool
    return y.reshape(bsz, seq, POOL_DIM) * scale


def odd_mixer(x, w_in, mu, w0, w2, a0, a2, g2, k_k, k_a, r_k, lnx_g, lnx_b,
              w_pool, b_pool, pool_scale, w_out):
    h = x @ w_in
    y_rw = rwkv7_time_mix(h[..., :RW_IN_DIM], mu, w0, w2, a0, a2, g2, k_k, k_a, r_k,
                          lnx_g, lnx_b)
    y_pool = multiscale_pool(h[..., RW_IN_DIM:], w_pool, b_pool, pool_scale)
    return jnp.concatenate([y_rw, y_pool], axis=-1) @ w_out


def setup_inputs(seed: int = 0) -> dict:
    key = jax.random.key(seed)
    ks = jax.random.split(key, 27)
    f32 = jnp.float32

    def nrm(k, shape, std):
        return std * jax.random.normal(k, shape, f32)

    return {
        "x": jax.random.normal(ks[0], (BATCH, SEQ, D_MODEL), f32),
        "ffn_in": nrm(ks[1], (DEPTH, 2, D_MODEL, 2 * D_FF), D_MODEL ** -0.5),
        "ffn_out": nrm(ks[2], (DEPTH, 2, D_FF, D_MODEL), DN_BETA * D_FF ** -0.5),
        "ln_g": 1.0 + nrm(ks[3], (DEPTH, 3, D_MODEL), 0.02),
        "ln_b": nrm(ks[4], (DEPTH, 3, D_MODEL), 0.02),
        "e_w_in": nrm(ks[5], (N_EVEN, D_MODEL, IN0_DIM), D_MODEL ** -0.5),
        "e_w_dw": nrm(ks[6], (N_EVEN, CONV_WIDTH, CONV_DIM), CONV_WIDTH ** -0.5),
        "e_b_dw": nrm(ks[7], (N_EVEN, CONV_DIM), 0.02),
        "e_conv_g": 1.0 + nrm(ks[8], (N_EVEN, CONV_DIM), 0.02),
        "e_conv_b": nrm(ks[9], (N_EVEN, CONV_DIM), 0.02),
        "e_w_out": nrm(ks[10], (N_EVEN, MIX0_DIM, D_MODEL), DN_BETA * MIX0_DIM ** -0.5),
        "o_w_in": nrm(ks[11], (N_ODD, D_MODEL, IN1_DIM), D_MODEL ** -0.5),
        "o_mu": jax.random.uniform(ks[12], (N_ODD, RW_IN_DIM), f32, 0.0, 1.0),
        "o_w0": jax.random.uniform(ks[13], (N_ODD, RW_DIM), f32, -6.0, -1.0),
        "o_w2": nrm(ks[14], (N_ODD, DECAY_LORA, RW_DIM), 0.1 * DECAY_LORA ** -0.5),
        "o_a0": nrm(ks[15], (N_ODD, RW_DIM), 0.1),
        "o_a2": nrm(ks[16], (N_ODD, ICLR_LORA, RW_DIM), 0.1 * ICLR_LORA ** -0.5),
        "o_g2": nrm(ks[17], (N_ODD, GATE_LORA, RW_DIM), GATE_LORA ** -0.5),
        "o_k_k": 0.85 + nrm(ks[18], (N_ODD, RW_HEADS, RW_HEAD_DIM), 0.02),
        "o_k_a": 1.0 + nrm(ks[19], (N_ODD, RW_HEADS, RW_HEAD_DIM), 0.02),
        "o_r_k": nrm(ks[20], (N_ODD, RW_HEADS, RW_HEAD_DIM), 0.1),
        "o_lnx_g": 1.0 + nrm(ks[21], (N_ODD, RW_HEADS, RW_HEAD_DIM), 0.02),
        "o_lnx_b": nrm(ks[22], (N_ODD, RW_HEADS, RW_HEAD_DIM), 0.02),
        "o_w_pool": nrm(ks[23], (N_ODD, POOL_GROUPS, POOL_GROUP_DIM, POOL_GROUP_DIM), POOL_GROUP_DIM ** -0.5),
        "o_b_pool": nrm(ks[24], (N_ODD, POOL_GROUPS, POOL_GROUP_DIM), 0.02),
        "o_pool_scale": 0.5 + nrm(ks[25], (N_ODD, POOL_DIM), 0.1),
        "o_w_out": nrm(ks[26], (N_ODD, MIX1_DIM, D_MODEL), DN_BETA * MIX1_DIM ** -0.5),
    }


def reference(x, ffn_in, ffn_out, ln_g, ln_b,
              e_w_in, e_w_dw, e_b_dw, e_conv_g, e_conv_b, e_w_out,
              o_w_in, o_mu, o_w0, o_w2, o_a0, o_a2, o_g2, o_k_k, o_k_a, o_r_k,
              o_lnx_g, o_lnx_b, o_w_pool, o_b_pool, o_pool_scale, o_w_out):
    for layer in range(DEPTH):
        f = swiglu(x, ffn_in[layer, 0], ffn_out[layer, 0])
        x = layer_norm(DN_ALPHA * x + FFN_RES * f, ln_g[layer, 0], ln_b[layer, 0])
        if layer % 2 == 0:
            i = layer // 2
            m = even_mixer(x, e_w_in[i], e_w_dw[i], e_b_dw[i], e_conv_g[i], e_conv_b[i], e_w_out[i])
        else:
            i = layer // 2
            m = odd_mixer(x, o_w_in[i], o_mu[i], o_w0[i], o_w2[i], o_a0[i], o_a2[i], o_g2[i],
                          o_k_k[i], o_k_a[i], o_r_k[i], o_lnx_g[i], o_lnx_b[i],
                          o_w_pool[i], o_b_pool[i], o_pool_scale[i], o_w_out[i])
        x = layer_norm(DN_ALPHA * x + m, ln_g[layer, 1], ln_b[layer, 1])
        f = swiglu(x, ffn_in[layer, 1], ffn_out[layer, 1])
        x = layer_norm(DN_ALPHA * x + FFN_RES * f, ln_g[layer, 2], ln_b[layer, 2])
    return x
```

```cpp
#include <hip/hip_runtime.h>
#include <hip/hip_cooperative_groups.h>
#include <cstdio>
#include <cstdint>
namespace cg = cooperative_groups;
#ifndef MK_N_LAUNCHES
#define MK_N_LAUNCHES 1
#endif
namespace pg8 {
#define PG8_LAS __attribute__((address_space(3)))
typedef unsigned short bf16_t;
typedef short bf16x8 __attribute__((ext_vector_type(8)));
typedef float f32x4 __attribute__((ext_vector_type(4)));
typedef unsigned u32x4 __attribute__((ext_vector_type(4)));
constexpr int BM = 256, BK = 64, HALF = 128, HTB = HALF * BK * 2  , STAGE_BYTES = 8 * HTB, NXCD = 8, WGM = 8;

__host__ __device__ __forceinline__ int lds_byte(int r, int c) { const int st = (r >> 4) * 2 + (c >> 5), rr = r & 15, cc = c & 31, ob = rr * 64 + cc * 2; return st * 1024 + (ob ^ (((ob >> 9) & 1) << 5)); }
__host__ __device__ __forceinline__ void stage_rc(int b, int& R, int& C) { const int st = b / 1024, sb = b % 1024, swz = sb ^ (((sb >> 9) & 1) << 5); R = (st >> 1) * 16 + swz / 64; C = (st & 1) * 32 + (swz % 64) / 2; }
__host__ __device__ __forceinline__ int perm32(int rho) { const int n = rho >> 4, i = rho & 15; return 8 * (i >> 2) + 4 * n + (i & 3); }

struct Unit { int pm, pn; };
struct Gemm { const bf16_t* A; const bf16_t* Bt; int M, N, K; };

struct StaticOrder {
    int nM, nN, nwg, G, c;
    __host__ __device__ void init(int M, int N, int G_, int c_) { nM = M / BM; nN = N / BM; nwg = nM * nN; G = G_; c = c_; }
    __host__ __device__ bool next(int i, Unit& u) const {
        const long L = (long)i * G + c; if (L >= nwg) return false;
        int wgid = (int)L; { const int q = nwg / NXCD, r = nwg % NXCD, xcd = wgid % NXCD, off = wgid / NXCD; wgid = (xcd < r ? xcd * (q + 1) : r * (q + 1) + (xcd - r) * q) + off; }
        const int nig = WGM * nN, gid = wgid / nig, fm = gid * WGM, gsz = (nM - fm) < WGM ? (nM - fm) : WGM;
        u.pm = fm + ((wgid % nig) % gsz); u.pn = (wgid % nig) / gsz; return true;
    }
    __device__ __forceinline__ void a_ready(const Unit&) const {}
    __device__ __forceinline__ void done(const Unit&) const {}
};

__device__ __forceinline__ unsigned cvt_pk_bf16(float lo, float hi) { unsigned r; asm volatile("v_cvt_pk_bf16_f32 %0, %1, %2" : "=v"(r) : "v"(lo), "v"(hi)); return r; }
typedef float f32x2 __attribute__((ext_vector_type(2)));
__device__ __forceinline__ f32x2 gelu_pk(f32x2 v) {
    const f32x2 av = __builtin_elementwise_abs(v), d = av * 0.2316418882f + 1.0f;
    f32x2 t; t.x = __builtin_amdgcn_rcpf(d.x); t.y = __builtin_amdgcn_rcpf(d.y);
    f32x2 q = t * 0.5307027145f + (-0.7265760135f); q = q * t + 0.7107068705f; q = q * t + (-0.142248368f); q = q * t + 0.127414796f; q = q * t;
    const f32x2 s = (v * v) * (-0.72134752044f);
    f32x2 e; e.x = __builtin_amdgcn_exp2f(s.x); e.y = __builtin_amdgcn_exp2f(s.y);
    const f32x2 m = v * (q * e), r = v - m;
    f32x2 o; o.x = v.x < 0.f ? m.x : r.x; o.y = v.y < 0.f ? m.y : r.y; return o;
}

template <int ACT  > struct EpiBf16 {
    static constexpr bool PERM = true, AFTER_DRAIN = false; static_assert(ACT == 0 || ACT == 1, "EpiBf16: ACT is 0 (none) or 1 (gelu_pk)");
    bf16_t* O; int ldc; const float* bias; int split_cols; size_t split_stride; float scale0;
    __device__ __forceinline__ void operator()(const f32x4 (&acc)[2][2][4][2], const Unit& u, int wr, int wc, int fr, int fq) const {
        const int row0 = u.pm * BM + wr * 64 + fr; int colt = u.pn * BM; bf16_t* base = O;
        float sc = 1.f; if (split_cols) { const int t = colt / split_cols; base += (size_t)t * split_stride; colt -= t * split_cols; if (t == 0) sc = scale0; }
        const int col0 = colt + wc * 32 + 8 * fq, bcol0 = u.pn * BM + wc * 32 + 8 * fq;
        f32x4 bv[2][2];
#pragma unroll
        for (int bj = 0; bj < 2; ++bj)
#pragma unroll
            for (int n = 0; n < 2; ++n) bv[bj][n] = bias ? *(const f32x4*)(bias + bcol0 + bj * HALF + 4 * n) : (f32x4){0.f, 0.f, 0.f, 0.f};
#pragma unroll
        for (int ai = 0; ai < 2; ++ai)
#pragma unroll
            for (int m = 0; m < 4; ++m) { bf16_t* rowp = base + (size_t)(row0 + ai * HALF + m * 16) * ldc + col0;
#pragma unroll
                for (int bj = 0; bj < 2; ++bj) { f32x4 v0 = acc[ai][bj][m][0] + bv[bj][0], v1 = acc[ai][bj][m][1] + bv[bj][1];
                    if (ACT == 1) { f32x2 a = gelu_pk((f32x2){v0[0], v0[1]}), b = gelu_pk((f32x2){v0[2], v0[3]}), c = gelu_pk((f32x2){v1[0], v1[1]}), d = gelu_pk((f32x2){v1[2], v1[3]});
                        v0 = (f32x4){a.x, a.y, b.x, b.y}; v1 = (f32x4){c.x, c.y, d.x, d.y}; }
                    v0 = v0 * sc; v1 = v1 * sc; u32x4 w; w.x = cvt_pk_bf16(v0[0], v0[1]); w.y = cvt_pk_bf16(v0[2], v0[3]); w.z = cvt_pk_bf16(v1[0], v1[1]); w.w = cvt_pk_bf16(v1[2], v1[3]);
                    *(u32x4*)(rowp + bj * HALF) = w; } }
    }
};
struct EpiSwiglu {
    static constexpr bool PERM = true, AFTER_DRAIN = false;
    bf16_t* O; int ldc;
    __device__ __forceinline__ void operator()(const f32x4 (&acc)[2][2][4][2], const Unit& u, int wr, int wc, int fr, int fq) const {
        const int row0 = u.pm * BM + wr * 64 + fr, col0 = u.pn * HALF + wc * 32 + 8 * fq;
#pragma unroll
        for (int ai = 0; ai < 2; ++ai)
#pragma unroll
            for (int m = 0; m < 4; ++m) { bf16_t* rowp = O + (size_t)(row0 + ai * HALF + m * 16) * ldc + col0;
                float hv[8];
#pragma unroll
                for (int n = 0; n < 2; ++n)
#pragma unroll
                    for (int e = 0; e < 4; ++e) { const float g = acc[ai][0][m][n][e], up = acc[ai][1][m][n][e]; hv[n * 4 + e] = g * up * __builtin_amdgcn_rcpf(1.0f + __expf(-g)); }
                u32x4 w; w.x = cvt_pk_bf16(hv[0], hv[1]); w.y = cvt_pk_bf16(hv[2], hv[3]); w.z = cvt_pk_bf16(hv[4], hv[5]); w.w = cvt_pk_bf16(hv[6], hv[7]);
                *(u32x4*)rowp = w; }
    }
};
struct EpiRes {
    static constexpr bool PERM = false, AFTER_DRAIN = false;
    const float* base; float* out; int ldc; float alpha, s;
    __device__ __forceinline__ void operator()(const f32x4 (&acc)[2][2][4][2], const Unit& u, int wr, int wc, int fr, int fq) const {
        const int col0 = u.pn * BM + wc * 32 + 4 * fq;
#pragma unroll
        for (int ai = 0; ai < 2; ++ai)
#pragma unroll
            for (int m = 0; m < 4; ++m) { const int r = u.pm * BM + ai * HALF + wr * 64 + m * 16 + fr; const size_t off = (size_t)r * ldc + col0;
#pragma unroll
                for (int bj = 0; bj < 2; ++bj)
#pragma unroll
                    for (int n = 0; n < 2; ++n) { const f32x4 bs = *(const f32x4*)(base + off + bj * HALF + n * 16); const f32x4 o = bs * alpha + acc[ai][bj][m][n] * s; *(f32x4*)(out + off + bj * HALF + n * 16) = o; } }
    }
};

template <class Epi, class Sched, bool ALIGN_EPI = false, bool SP2 = false>
__device__ __forceinline__ void gemm_phase(PG8_LAS unsigned char* lds, const Gemm g, const Sched& S, const Epi& E) {
    const int tid = threadIdx.x, wid = __builtin_amdgcn_readfirstlane(tid >> 6), lane = tid & 63, wr = wid >> 2, wc = wid & 3, fr = lane & 15, fq = lane >> 4;
    const int K = g.K, nt = K / BK;
    unsigned voffA[2], voffB[2];
#pragma unroll
    for (int i = 0; i < 2; ++i) { int R, C; stage_rc(tid * 16 + i * 8192, R, C); const int Rb = Epi::PERM ? ((R & ~31) + perm32(R & 31)) : R;
        voffA[i] = (unsigned)(R * K + C) * 2u; voffB[i] = (unsigned)(Rb * K + C) * 2u; }
    const size_t kstep = (size_t)(BK * 2);
    const size_t hstep = (size_t)HALF * K * 2;
    const size_t tstep = 2 * hstep;
    const unsigned ldsw = (unsigned)wid * 1024u;
    const int aoff = lds_byte(wr * 64 + fr, fq * 8), boff = lds_byte(wc * 32 + fr, fq * 8);
#define PG8_SA(b, h) (((b) * 2 + (h)) * HTB)
#define PG8_SB(b, h) ((4 + (b) * 2 + (h)) * HTB)
#define PG8_STAGE(bufoff, gbase, voff) do { _Pragma("unroll") for (int _i = 0; _i < 2; ++_i) \
        __builtin_amdgcn_global_load_lds((const unsigned*)((const char*)(gbase) + (voff)[_i]), (PG8_LAS unsigned*)(lds + (bufoff) + ldsw + _i * 8192), 16, 0, 0); } while (0)
#define PG8_LDA(dst, b, h) do { _Pragma("unroll") for (int m = 0; m < 4; ++m) _Pragma("unroll") for (int k = 0; k < 2; ++k) dst[m][k] = *(const PG8_LAS bf16x8*)(lds + PG8_SA(b, h) + aoff + m * 2048 + k * 1024); } while (0)
#define PG8_LDB(dst, b, h) do { _Pragma("unroll") for (int n = 0; n < 2; ++n) _Pragma("unroll") for (int k = 0; k < 2; ++k) dst[n][k] = *(const PG8_LAS bf16x8*)(lds + PG8_SB(b, h) + boff + n * 2048 + k * 1024); } while (0)
#define PG8_MMA(ai, bj, At, Bt) do { __builtin_amdgcn_s_setprio(1); _Pragma("unroll") for (int m = 0; m < 4; ++m) _Pragma("unroll") for (int n = 0; n < 2; ++n) _Pragma("unroll") for (int k = 0; k < 2; ++k) \
        acc[ai][bj][m][n] = __builtin_amdgcn_mfma_f32_16x16x32_bf16(Bt[n][k], At[m][k], acc[ai][bj][m][n], 0, 0, 0); __builtin_amdgcn_s_setprio(0); } while (0)
#define PG8_WAIT_V(n) asm volatile("s_waitcnt vmcnt(" #n ")" ::: "memory")
#define PG8_WAIT_L(n) asm volatile("s_waitcnt lgkmcnt(" #n ")" ::: "memory")
#define PG8_BAR __builtin_amdgcn_s_barrier()
#define PG8_SCHED __builtin_amdgcn_sched_barrier(0)
    Unit cur, nxt; int ui = 0;
    if (!S.next(0, cur)) return;
    f32x4 acc[2][2][4][2];
#pragma unroll
    for (int a = 0; a < 2; ++a)
#pragma unroll
        for (int b = 0; b < 2; ++b)
#pragma unroll
            for (int m = 0; m < 4; ++m)
#pragma unroll
                for (int n = 0; n < 2; ++n) acc[a][b][m][n] = (f32x4){0.f, 0.f, 0.f, 0.f};
    bf16x8 At[4][2], B0[2][2], B1[2][2];
    const char* cA = (const char*)g.A + (size_t)cur.pm * tstep; const char* cB = (const char*)g.Bt + (size_t)cur.pn * tstep;
    S.a_ready(cur);
    if constexpr (SP2) {
        PG8_STAGE(PG8_SB(0, 0), cB, voffB); PG8_STAGE(PG8_SB(0, 1), cB + hstep, voffB); PG8_STAGE(PG8_SA(0, 0), cA, voffA); PG8_STAGE(PG8_SA(0, 1), cA + hstep, voffA);
        if (wr == 1) PG8_BAR;
        PG8_WAIT_V(2); PG8_BAR;
        PG8_STAGE(PG8_SB(1, 0), cB + kstep, voffB); PG8_STAGE(PG8_SA(1, 0), cA + kstep, voffA); PG8_STAGE(PG8_SB(1, 1), cB + hstep + kstep, voffB);
        PG8_WAIT_V(6); PG8_BAR;
    } else {
        PG8_STAGE(PG8_SB(0, 0), cB, voffB); PG8_STAGE(PG8_SA(0, 0), cA, voffA); PG8_STAGE(PG8_SB(0, 1), cB + hstep, voffB); PG8_STAGE(PG8_SA(0, 1), cA + hstep, voffA);
        if (wr == 1) PG8_BAR;
        PG8_WAIT_V(4); PG8_BAR;
        PG8_STAGE(PG8_SB(1, 0), cB + kstep, voffB); PG8_STAGE(PG8_SA(1, 0), cA + kstep, voffA); PG8_STAGE(PG8_SB(1, 1), cB + hstep + kstep, voffB);
        PG8_WAIT_V(6); PG8_BAR;
    }
    for (;;) {
        const bool has_next = S.next(ui + 1, nxt);
        const char* nA = has_next ? (const char*)g.A + (size_t)nxt.pm * tstep : cA; const char* nB = has_next ? (const char*)g.Bt + (size_t)nxt.pn * tstep : cB;
        for (int t = 0; t < nt; t += 2) {
            const bool last = (t == nt - 2);
            const char* a1 = cA + (size_t)(t + 1) * kstep;
            const char* a2 = last ? nA : cA + (size_t)(t + 2) * kstep; const char* b2 = last ? nB : cB + (size_t)(t + 2) * kstep;
            const char* a3 = a2 + kstep; const char* b3 = b2 + kstep;
            if (last && has_next) S.a_ready(nxt);
            if constexpr (SP2) {
            PG8_LDB(B0, 0, 0); PG8_LDB(B1, 0, 1); PG8_SCHED; PG8_LDA(At, 0, 0); PG8_STAGE(PG8_SA(1, 1), a1 + hstep, voffA);
            PG8_WAIT_V(8); PG8_WAIT_L(0); PG8_BAR; PG8_MMA(0, 0, At, B0); PG8_MMA(0, 1, At, B1); PG8_BAR; PG8_SCHED;
            PG8_LDA(At, 0, 1); PG8_STAGE(PG8_SB(0, 0), b2, voffB); PG8_STAGE(PG8_SB(0, 1), b2 + hstep, voffB); PG8_STAGE(PG8_SA(0, 0), a2, voffA);
            PG8_WAIT_V(8); PG8_WAIT_L(0); PG8_BAR; PG8_MMA(1, 0, At, B0); PG8_MMA(1, 1, At, B1); PG8_BAR; PG8_SCHED;
            PG8_LDB(B0, 1, 0); PG8_LDB(B1, 1, 1); PG8_SCHED; PG8_LDA(At, 1, 0); PG8_STAGE(PG8_SA(0, 1), a2 + hstep, voffA);
            PG8_WAIT_V(8); PG8_WAIT_L(0); PG8_BAR; PG8_MMA(0, 0, At, B0); PG8_MMA(0, 1, At, B1); PG8_BAR; PG8_SCHED;
            PG8_LDA(At, 1, 1); PG8_STAGE(PG8_SB(1, 0), b3, voffB); PG8_STAGE(PG8_SB(1, 1), b3 + hstep, voffB); PG8_STAGE(PG8_SA(1, 0), a3, voffA);
            PG8_WAIT_V(8); PG8_WAIT_L(0); PG8_BAR; PG8_MMA(1, 0, At, B0); PG8_MMA(1, 1, At, B1); PG8_BAR; PG8_SCHED;
            } else {
            PG8_LDB(B0, 0, 0); PG8_SCHED; PG8_LDA(At, 0, 0); PG8_STAGE(PG8_SA(1, 1), a1 + hstep, voffA);
            PG8_WAIT_L(8); PG8_BAR; PG8_WAIT_L(0); PG8_MMA(0, 0, At, B0); PG8_BAR; PG8_SCHED;
            PG8_LDB(B1, 0, 1); PG8_STAGE(PG8_SB(0, 0), b2, voffB);
            PG8_BAR; PG8_WAIT_L(0); PG8_MMA(0, 1, At, B1); PG8_BAR;
            PG8_LDA(At, 0, 1); PG8_STAGE(PG8_SA(0, 0), a2, voffA);
            PG8_BAR; PG8_WAIT_L(0); PG8_MMA(1, 0, At, B0); PG8_BAR; PG8_SCHED;
            PG8_STAGE(PG8_SB(0, 1), b2 + hstep, voffB);
            PG8_WAIT_V(6); PG8_BAR; PG8_MMA(1, 1, At, B1); PG8_BAR;
            PG8_LDB(B0, 1, 0); PG8_SCHED; PG8_LDA(At, 1, 0); PG8_STAGE(PG8_SA(0, 1), a2 + hstep, voffA);
            PG8_WAIT_L(8); PG8_BAR; PG8_WAIT_L(0); PG8_MMA(0, 0, At, B0); PG8_BAR; PG8_SCHED;
            PG8_LDB(B1, 1, 1); PG8_STAGE(PG8_SB(1, 0), b3, voffB);
            PG8_BAR; PG8_WAIT_L(0); PG8_MMA(0, 1, At, B1); PG8_BAR;
            PG8_LDA(At, 1, 1); PG8_STAGE(PG8_SA(1, 0), a3, voffA);
            PG8_BAR; PG8_WAIT_L(0); PG8_MMA(1, 0, At, B0); PG8_BAR; PG8_SCHED;
            PG8_STAGE(PG8_SB(1, 1), b3 + hstep, voffB);
            PG8_WAIT_V(6); PG8_BAR; PG8_MMA(1, 1, At, B1); PG8_BAR;
            }
        }
        if constexpr (ALIGN_EPI) { if (wr == 0) PG8_BAR; }
        if constexpr (!Epi::AFTER_DRAIN) { E(acc, cur, wr, wc, fr, fq); S.done(cur); }
        if (!has_next) break;
#pragma unroll
        for (int a = 0; a < 2; ++a)
#pragma unroll
            for (int b = 0; b < 2; ++b)
#pragma unroll
                for (int m = 0; m < 4; ++m)
#pragma unroll
                    for (int n = 0; n < 2; ++n) acc[a][b][m][n] = (f32x4){0.f, 0.f, 0.f, 0.f};
        cur = nxt; cA = nA; cB = nB; ++ui;
        if constexpr (ALIGN_EPI) { if (wr == 1) PG8_BAR; }
    }
    PG8_WAIT_V(0);
    if constexpr (!ALIGN_EPI) { if (wr == 0) PG8_BAR; }
    PG8_BAR;
    if constexpr (Epi::AFTER_DRAIN) { E.fused(acc, cur, wr, wc, fr, fq, lds, wid, lane); S.done(cur); }
#undef PG8_SA
#undef PG8_SB
#undef PG8_STAGE
#undef PG8_LDA
#undef PG8_LDB
#undef PG8_MMA
#undef PG8_WAIT_V
#undef PG8_WAIT_L
#undef PG8_BAR
#undef PG8_SCHED
}
}
#define LAS __attribute__((address_space(3)))
typedef unsigned short bf16;
typedef float f32x4 __attribute__((ext_vector_type(4)));
typedef float f32x16 __attribute__((ext_vector_type(16)));
typedef short bf16x8 __attribute__((ext_vector_type(8)));
typedef unsigned v4u __attribute__((ext_vector_type(4)));
typedef unsigned v2u __attribute__((ext_vector_type(2)));
constexpr int NWAVES = 8, NTHR = 512;
constexpr int M = 32768, SEQ = 8192, D = 1024, DFF = 2816, NFF = 5632, IN0 = 2560, IN1 = 2304, RWD = 512;
constexpr float DN_ALPHA = 1.41421356237f, LN_EPS = 1e-5f, GN_EPS = 64e-5f;
constexpr size_t MiB = 1u << 20;
constexpr size_t WS_WFI = 1 * MiB, WFI_STRIDE = 11 * MiB;
constexpr size_t WS_WFO = 45 * MiB, WFO_STRIDE = 11 * MiB / 2;
constexpr size_t WS_EIN = 67 * MiB, WS_EOUT = 72 * MiB, WS_OIN = 74 * MiB, WS_OOUT = 78 * MiB + 512 * 1024;
constexpr size_t WS_XN = 90 * MiB;
constexpr size_t WS_H = 154 * MiB;
constexpr size_t WS_ARR = 298 * MiB;
constexpr size_t WS_MIX = 426 * MiB;
constexpr size_t WS_BON = 490 * MiB;
constexpr size_t WS_END = 492 * MiB;
constexpr int LDS_BYTES = 147456;
constexpr int NPH = 23;

__device__ __forceinline__ float bf2f(bf16 v) { return __uint_as_float((unsigned)v << 16); }
__device__ __forceinline__ unsigned f2bf(float f) { unsigned u = __float_as_uint(f); return (u + 0x7fffu + ((u >> 16) & 1u)) >> 16; }
__device__ __forceinline__ unsigned pk2(float lo, float hi) { return f2bf(lo) | (f2bf(hi) << 16); }
__device__ __forceinline__ float wave_sum(float v) {
#pragma unroll
    for (int o = 1; o < 64; o <<= 1) v += __shfl_xor(v, o);
    return v;
}
__device__ __forceinline__ float sigmoidf_(float x) { return 1.0f / (1.0f + __expf(-x)); }
__device__ __forceinline__ float softplusf_(float x) { return fmaxf(x, 0.f) + __logf(1.0f + __expf(-fabsf(x))); }

struct Args { const float* in[27]; float* out; unsigned char* ws; int ph_lo, ph_hi; };

__device__ __forceinline__ void transpose_item(const float* W, int K, int N, bf16* WT, int mode, LAS float* scr, int item, int lane) {
    const int nblk = N / 32, kb = item / nblk, nb = item % nblk, k0 = 64 * kb, n0 = 32 * nb;
    int d0 = n0;
    if (mode == 1) { if (n0 < DFF) d0 = (n0 >> 7) * 256 + (n0 & 127); else { const int n2 = n0 - DFF; d0 = (n2 >> 7) * 256 + 128 + (n2 & 127); } }
#pragma unroll 8
    for (int i = 0; i < 32; ++i) { const int kk = 2 * i + (lane >> 5); scr[kk * 33 + (lane & 31)] = W[(size_t)(k0 + kk) * N + n0 + (lane & 31)]; }
    asm volatile("s_waitcnt lgkmcnt(0)" ::: "memory");
    const int c = lane & 7;
#pragma unroll
    for (int j = 0; j < 4; ++j) { const int n = (lane >> 3) + 8 * j; const LAS float* s = scr + (8 * c) * 33 + n;
        v4u o; o.x = pk2(s[0 * 33], s[1 * 33]); o.y = pk2(s[2 * 33], s[3 * 33]); o.z = pk2(s[4 * 33], s[5 * 33]); o.w = pk2(s[6 * 33], s[7 * 33]);
        *(v4u*)(WT + (size_t)(d0 + n) * K + k0 + 8 * c) = o; }
    asm volatile("s_waitcnt lgkmcnt(0)" ::: "memory");
}

__device__ __forceinline__ void ln_phase(float* X, bf16* XN, const float* g, const float* b, bool write_xn, int gw, int NGW, int lane) {
    for (int m = gw; m < M; m += NGW) {
        f32x4* xr = (f32x4*)(X + (size_t)m * D) + lane;
        f32x4 v[4]; float s = 0.f;
#pragma unroll
        for (int j = 0; j < 4; ++j) { v[j] = xr[64 * j]; s += (v[j].x + v[j].y) + (v[j].z + v[j].w); }
        const float mean = wave_sum(s) * (1.f / D); float s2 = 0.f;
#pragma unroll
        for (int j = 0; j < 4; ++j) { v[j] = v[j] - mean; s2 += (v[j].x * v[j].x + v[j].y * v[j].y) + (v[j].z * v[j].z + v[j].w * v[j].w); }
        const float rstd = rsqrtf(wave_sum(s2) * (1.f / D) + LN_EPS);
        v2u* o8 = (v2u*)(XN + (size_t)m * D) + lane;
#pragma unroll
        for (int j = 0; j < 4; ++j) { const f32x4 gg = ((const f32x4*)g)[lane + 64 * j], bb = ((const f32x4*)b)[lane + 64 * j]; const f32x4 o = v[j] * rstd * gg + bb; xr[64 * j] = o;
            if (write_xn) { v2u w; w.x = pk2(o.x, o.y); w.y = pk2(o.z, o.w); o8[64 * j] = w; } }
    }
}

__device__ __forceinline__ void conv_unit(const bf16* P0, bf16* MIX, const float* wdw, const float* bdw, const float* cgam, const float* cbet, LAS float* lf, int unit, int tid, int wave, int lane) {
    const int t0g = unit * 32, tseq0 = t0g & (SEQ - 1);
    float h[62];
#pragma unroll
    for (int i = 0; i < 62; ++i) { float val = 0.f;
        if (tseq0 - 30 + i >= 0) { const size_t row = (size_t)(t0g - 30 + i); const float a = bf2f(P0[row * IN0 + tid]), g = bf2f(P0[row * IN0 + 512 + tid]); val = a * sigmoidf_(g); }
        h[i] = val; }
    float acc[32]; const float bias = bdw[tid];
#pragma unroll
    for (int tt = 0; tt < 32; ++tt) acc[tt] = bias;
#pragma unroll
    for (int j = 0; j < 31; ++j) { const float w = wdw[j * 512 + tid];
#pragma unroll
        for (int tt = 0; tt < 32; ++tt) acc[tt] = fmaf(w, h[tt + j], acc[tt]); }
#pragma unroll
    for (int tt = 0; tt < 32; ++tt) lf[tt * 512 + tid] = acc[tt];
    __syncthreads();
#pragma unroll 1
    for (int q = 0; q < 4; ++q) { const int tt = wave * 4 + q; float v[8]; float s = 0.f;
#pragma unroll
        for (int k = 0; k < 8; ++k) { v[k] = lf[tt * 512 + lane + 64 * k]; s += v[k]; }
        const float mean = wave_sum(s) * (1.f / 512.f); float s2 = 0.f;
#pragma unroll
        for (int k = 0; k < 8; ++k) { v[k] -= mean; s2 += v[k] * v[k]; }
        const float rstd = rsqrtf(wave_sum(s2) * (1.f / 512.f) + LN_EPS);
#pragma unroll
        for (int k = 0; k < 8; ++k) { const int c = lane + 64 * k; float y = v[k] * rstd * cgam[c] + cbet[c]; y = y * sigmoidf_(y); MIX[(size_t)(t0g + tt) * D + c] = (bf16)f2bf(y); } }
    __syncthreads();
}

__device__ __forceinline__ int crow(int reg, int h) { return (reg & 3) + 8 * (reg >> 2) + 4 * h; }
__device__ __forceinline__ void attn_unit(const bf16* P0, bf16* MIX, int u, int lane) {
    const int b = u >> 11, hd = (u >> 8) & 7, qb = u & 255;
    const int r = lane & 31, hh = lane >> 5;
    const size_t rowb = (size_t)b * SEQ;
    const bf16* Qp = P0 + (rowb + qb * 32 + r) * IN0 + 1024 + hd * 64 + 8 * hh;
    bf16x8 qf[4];
#pragma unroll
    for (int c = 0; c < 4; ++c) qf[c] = *(const bf16x8*)(Qp + 16 * c);
    f32x16 o0, o1;
#pragma unroll
    for (int i = 0; i < 16; ++i) { o0[i] = 0.f; o1[i] = 0.f; }
    float R = 0.f;
    for (int kt = qb; kt >= 0; --kt) {
        const bf16* Kp = P0 + (rowb + kt * 32 + r) * IN0 + 1536 + hd * 64 + 8 * hh;
        f32x16 x;
#pragma unroll
        for (int i = 0; i < 16; ++i) x[i] = 0.f;
#pragma unroll
        for (int c = 0; c < 4; ++c) { const bf16x8 kf = *(const bf16x8*)(Kp + 16 * c); x = __builtin_amdgcn_mfma_f32_32x32x16_bf16(kf, qf[c], x, 0, 0, 0); }
        const bool diag = (kt == qb);
        float sp[16], z[16];
#pragma unroll
        for (int i = 0; i < 16; ++i) { z[i] = x[i] * 0.125f; const bool valid = !diag || (crow(i, hh) < r); sp[i] = valid ? softplusf_(z[i]) : 0.f; }
        float T[4], PT[4];
#pragma unroll
        for (int g = 0; g < 4; ++g) { sp[4 * g + 2] += sp[4 * g + 3]; sp[4 * g + 1] += sp[4 * g + 2]; sp[4 * g] += sp[4 * g + 1]; T[g] = sp[4 * g]; }
#pragma unroll
        for (int g = 0; g < 4; ++g) PT[g] = __shfl_xor(T[g], 32);
        float after[4]; float own = 0.f, part = 0.f;
#pragma unroll
        for (int g = 3; g >= 0; --g) { const float pincl = part + PT[g]; after[g] = own + (hh == 0 ? pincl : part); own += T[g]; part = pincl; }
        float p[16];
#pragma unroll
        for (int i = 0; i < 16; ++i) { const bool valid = !diag || (crow(i, hh) < r); const float cs = sp[i] + after[i >> 2] + R; p[i] = valid ? __expf(z[i] - cs) : 0.f; }
        R += own + part;
#pragma unroll
        for (int s = 0; s < 2; ++s) {
            v4u pw; pw.x = pk2(p[8 * s], p[8 * s + 1]); pw.y = pk2(p[8 * s + 2], p[8 * s + 3]); pw.z = pk2(p[8 * s + 4], p[8 * s + 5]); pw.w = pk2(p[8 * s + 6], p[8 * s + 7]);
            const bf16x8 pf = __builtin_bit_cast(bf16x8, pw);
            bf16x8 v0, v1;
#pragma unroll
            for (int j = 0; j < 8; ++j) { const int key = kt * 32 + 16 * s + 8 * (j >> 2) + 4 * hh + (j & 3); const bf16* vp = P0 + (rowb + key) * IN0 + 2048 + hd * 64 + r; v0[j] = (short)vp[0]; v1[j] = (short)vp[32]; }
            o0 = __builtin_amdgcn_mfma_f32_32x32x16_bf16(v0, pf, o0, 0, 0, 0);
            o1 = __builtin_amdgcn_mfma_f32_32x32x16_bf16(v1, pf, o1, 0, 0, 0);
        }
        if (__all(R > 44.5f)) break;
    }
    bf16* Op = MIX + (rowb + qb * 32 + r) * D + 512 + hd * 64 + 4 * hh;
#pragma unroll
    for (int g = 0; g < 4; ++g) {
        v2u w0; w0.x = pk2(o0[4 * g], o0[4 * g + 1]); w0.y = pk2(o0[4 * g + 2], o0[4 * g + 3]); *(v2u*)(Op + 8 * g) = w0;
        v2u w1; w1.x = pk2(o1[4 * g], o1[4 * g + 1]); w1.y = pk2(o1[4 * g + 2], o1[4 * g + 3]); *(v2u*)(Op + 32 + 8 * g) = w1;
    }
}

struct OddW { const float *mu, *w0, *w2, *a0, *a2, *g2, *k_k, *k_a, *r_k, *wpool, *bpool, *pscale; };
__device__ __forceinline__ void prep_unit(const bf16* P1, const OddW& W, bf16* Ar, bf16* Ae, bf16* Ak, bf16* Av, bf16* Akk, bf16* Ab, bf16* MIX, float* BON, LAS float* lf, int unit, int tid, int wave, int lane) {
    LAS float* lora = lf;
    LAS float* pooled = lf + 4096;
    const int t0g = unit * 16, tseq0 = t0g & (SEQ - 1);
#pragma unroll
    for (int k = 0; k < 8; ++k) { const int idx = tid + 512 * k, tok = idx >> 8, i = idx & 255; const size_t row = (size_t)(t0g + tok);
        const float cur = bf2f(P1[row * IN1 + 1536 + i]); const float prev = (tseq0 + tok > 0) ? bf2f(P1[(row - 1) * IN1 + 1536 + i]) : 0.f;
        const float x = cur + (prev - cur) * W.mu[1536 + i];
        lora[idx] = (i < 64) ? tanhf(x) : ((i < 128) ? x : sigmoidf_(x)); }
    const int grp = tid >> 7, win = 2 << grp;
    {
        float arr[31];
#pragma unroll
        for (int i = 0; i < 31; ++i) arr[i] = (tseq0 - 15 + i >= 0) ? bf2f(P1[(size_t)(t0g - 15 + i) * IN1 + 1792 + tid]) : 0.f;
#pragma unroll
        for (int tok = 0; tok < 16; ++tok) { float s = 0.f;
#pragma unroll
            for (int j = 0; j < 16; ++j) if (j < win) s += arr[15 + tok - j];
            const int cnt = min(tseq0 + tok + 1, win);
            pooled[tok * 512 + tid] = s / (float)cnt - arr[15 + tok]; }
    }
    __syncthreads();
    float aw[16], aa[16], ag[16], ap[16];
#pragma unroll
    for (int t = 0; t < 16; ++t) { aw[t] = 0.f; aa[t] = 0.f; ag[t] = 0.f; ap[t] = 0.f; }
#pragma unroll 1
    for (int i = 0; i < 64; i += 4) { float w[4], a[4];
#pragma unroll
        for (int e = 0; e < 4; ++e) { w[e] = W.w2[(i + e) * 512 + tid]; a[e] = W.a2[(i + e) * 512 + tid]; }
#pragma unroll
        for (int t = 0; t < 16; ++t) { const f32x4 lw = *(const LAS f32x4*)(lora + t * 256 + i), la = *(const LAS f32x4*)(lora + t * 256 + 64 + i);
            aw[t] += lw.x * w[0] + lw.y * w[1] + lw.z * w[2] + lw.w * w[3]; aa[t] += la.x * a[0] + la.y * a[1] + la.z * a[2] + la.w * a[3]; } }
#pragma unroll 1
    for (int i = 0; i < 128; i += 4) { float g[4], pw[4];
#pragma unroll
        for (int e = 0; e < 4; ++e) { g[e] = W.g2[(i + e) * 512 + tid]; pw[e] = W.wpool[(size_t)(grp * 128 + i + e) * 128 + (tid & 127)]; }
#pragma unroll
        for (int t = 0; t < 16; ++t) { const f32x4 lg = *(const LAS f32x4*)(lora + t * 256 + 128 + i), lp = *(const LAS f32x4*)(pooled + t * 512 + grp * 128 + i);
            ag[t] += lg.x * g[0] + lg.y * g[1] + lg.z * g[2] + lg.w * g[3]; ap[t] += lp.x * pw[0] + lp.y * pw[1] + lp.z * pw[2] + lp.w * pw[3]; } }
    const float mu_r = W.mu[tid], mu_k = W.mu[512 + tid], mu_v = W.mu[1024 + tid];
    const float w0c = W.w0[tid], a0c = W.a0[tid], kkc = W.k_k[tid], kac = W.k_a[tid], rkc = W.r_k[tid], bp = W.bpool[tid], ps = W.pscale[tid];
#pragma unroll
    for (int t = 0; t < 16; ++t) { const size_t row = (size_t)(t0g + t); const bool first = (tseq0 + t == 0);
        const bf16* pc = P1 + row * IN1 + tid; const bf16* pp = pc - IN1;
        const float rc = bf2f(pc[0]), kc = bf2f(pc[512]), vc = bf2f(pc[1024]);
        const float rp = first ? 0.f : bf2f(pp[0]), kp_ = first ? 0.f : bf2f(pp[512]), vp = first ? 0.f : bf2f(pp[1024]);
        const float rr = rc + (rp - rc) * mu_r, kk_ = kc + (kp_ - kc) * mu_k, vv = vc + (vp - vc) * mu_v;
        const float wl = w0c + aw[t]; const float logw = -softplusf_(-wl) - 0.5f; const float ee = __expf(logw);
        const float ic = sigmoidf_(a0c + aa[t]);
        const float kkr = kk_ * kkc; const float ss = wave_sum(kkr * kkr); const float kkn = kkr * rsqrtf(fmaxf(ss, 1e-24f));
        const float kpm = kk_ * (1.0f + (ic - 1.0f) * kac);
        const float bon = wave_sum(rr * kpm * rkc);
        const size_t o = row * RWD + tid;
        Ar[o] = (bf16)f2bf(rr); Ae[o] = (bf16)f2bf(ee); Ak[o] = (bf16)f2bf(kpm); Av[o] = (bf16)f2bf(vv); Akk[o] = (bf16)f2bf(kkn); Ab[o] = (bf16)f2bf(kkn * ic);
        MIX[row * D + tid] = (bf16)f2bf(ag[t]);
        MIX[row * D + 512 + tid] = (bf16)f2bf((ap[t] + bp) * ps);
        if (lane == 0) BON[row * 8 + wave] = bon; }
    __syncthreads();
}

#define WAVE_RED(x) do { \
    x += __int_as_float(__builtin_amdgcn_update_dpp(0, __float_as_int(x), 0xB1, 0xF, 0xF, false)); \
    x += __int_as_float(__builtin_amdgcn_update_dpp(0, __float_as_int(x), 0x4E, 0xF, 0xF, false)); \
    x += __int_as_float(__builtin_amdgcn_update_dpp(0, __float_as_int(x), 0x141, 0xF, 0xF, false)); \
    x += __int_as_float(__builtin_amdgcn_update_dpp(0, __float_as_int(x), 0x140, 0xF, 0xF, false)); \
    x += __int_as_float(__builtin_amdgcn_update_dpp(0, __float_as_int(x), 0x142, 0xA, 0xF, false)); \
    x += __int_as_float(__builtin_amdgcn_update_dpp(0, __float_as_int(x), 0x143, 0xC, 0xF, false)); } while (0)
__device__ __forceinline__ void scan_unit(const bf16* Ar, const bf16* Ae, const bf16* Ak, const bf16* Av, const bf16* Akk, const bf16* Ab, float* Y, int u, int lane) {
    const int bh = u >> 6, i = u & 63, b = bh >> 3, hd = bh & 7;
    const size_t base = (size_t)b * SEQ * RWD + hd * 64;
    const bf16 *pr = Ar + base + lane, *pe = Ae + base + lane, *pk = Ak + base + lane, *pkk = Akk + base + lane, *pb = Ab + base + lane, *pv = Av + base + i;
    float* py = Y + base + i;
    constexpr int TB = 8;
    float S = 0.f;
    bf16 nr[TB], ne[TB], nk[TB], nkk[TB], nb[TB], nv[TB];
#pragma unroll
    for (int s = 0; s < TB; ++s) { const size_t o = (size_t)s * RWD; nr[s] = pr[o]; ne[s] = pe[o]; nk[s] = pk[o]; nkk[s] = pkk[o]; nb[s] = pb[o]; nv[s] = pv[o]; }
#pragma unroll 1
    for (int blk = 0; blk < SEQ / TB; ++blk) {
        float cr[TB], cw[TB], ck[TB], ca[TB], cb[TB], cv[TB];
#pragma unroll
        for (int s = 0; s < TB; ++s) { cr[s] = bf2f(nr[s]); cw[s] = __expf(-bf2f(ne[s])); ck[s] = bf2f(nk[s]); ca[s] = -bf2f(nkk[s]); cb[s] = bf2f(nb[s]); cv[s] = bf2f(nv[s]); }
        if (blk + 1 < SEQ / TB) {
#pragma unroll
            for (int s = 0; s < TB; ++s) { const size_t o = (size_t)((blk + 1) * TB + s) * RWD; nr[s] = pr[o]; ne[s] = pe[o]; nk[s] = pk[o]; nkk[s] = pkk[o]; nb[s] = pb[o]; nv[s] = pv[o]; }
        }
#pragma unroll
        for (int s = 0; s < TB; ++s) {
            float p = S * ca[s];
            WAVE_RED(p);
            const float sa = __int_as_float(__builtin_amdgcn_readlane(__float_as_int(p), 63));
            S = fmaf(S, cw[s], fmaf(sa, cb[s], cv[s] * ck[s]));
            float q = S * cr[s];
            WAVE_RED(q);
            if (lane == 63) py[(size_t)(blk * TB + s) * RWD] = q;
        }
    }
}

__device__ __forceinline__ void post_phase(const float* Y, const bf16* Av, const float* BON, bf16* MIX, const float* lg, const float* lb, int bid, int G, int tid, int wave, int lane) {
    const float g = lg[tid], bb = lb[tid];
    for (int m = bid; m < M; m += G) {
        const float y = Y[(size_t)m * RWD + tid];
        const float mean = wave_sum(y) * (1.f / 64.f); const float d = y - mean; const float var = wave_sum(d * d) * (1.f / 64.f);
        const float yn = d * rsqrtf(var + GN_EPS) * g + bb;
        const float o = (yn + BON[(size_t)m * 8 + wave] * bf2f(Av[(size_t)m * RWD + tid])) * bf2f(MIX[(size_t)m * D + tid]);
        MIX[(size_t)m * D + tid] = (bf16)f2bf(o);
    }
}

#ifndef EN0
#define EN0 1
#endif
#ifndef EN1
#define EN1 1
#endif
#ifndef EN2
#define EN2 1
#endif
#ifndef EN3
#define EN3 1
#endif
#ifndef EN4
#define EN4 1
#endif
#ifndef EN5
#define EN5 1
#endif
#ifndef EN7
#define EN7 1
#endif
#ifndef EN8
#define EN8 1
#endif
#ifndef EN9
#define EN9 1
#endif
__global__ void __launch_bounds__(NTHR, 2) mega_fwd(Args args) {
    extern __shared__ __attribute__((aligned(16))) unsigned char lds[];
    LAS unsigned char* L = (LAS unsigned char*)lds;
    LAS float* lf = (LAS float*)lds;
    cg::grid_group grid = cg::this_grid();
    const int tid0 = threadIdx.x;
    const int G = gridDim.x, NGW = G * NWAVES;
    unsigned char* ws0 = args.ws;
    const float* x_in = args.in[0]; const float* ffn_in = args.in[1]; const float* ffn_out = args.in[2]; const float* ln_g = args.in[3]; const float* ln_b = args.in[4];

    for (int ph = args.ph_lo; ph < args.ph_hi; ++ph) {
        if (ph > args.ph_lo) grid.sync();
        int tid = tid0; asm volatile("" : "+v"(tid));
        int bid = blockIdx.x; asm volatile("" : "+s"(bid));
        unsigned char* ws = ws0; asm volatile("" : "+s"(ws));
        const int lane = tid & 63, wave = __builtin_amdgcn_readfirstlane(tid >> 6), gw = bid * NWAVES + wave;
        float* X = args.out;
        bf16* XN = (bf16*)(ws + WS_XN); bf16* H = (bf16*)(ws + WS_H); bf16* MIX = (bf16*)(ws + WS_MIX);
        bf16* PB = (bf16*)(ws + WS_H);
        float* Y = (float*)(ws + WS_H);
        bf16* Ar = (bf16*)(ws + WS_ARR); bf16* Ae = Ar + (size_t)M * RWD; bf16* Ak = Ae + (size_t)M * RWD; bf16* Av = Ak + (size_t)M * RWD;
        bf16* Akk = (bf16*)(ws + WS_XN); bf16* Ab = Akk + (size_t)M * RWD;
        float* BON = (float*)(ws + WS_BON);
        int kind, par;
        switch (ph) {
            case 0: kind = 0; par = 0; break;
            case 1: kind = 1; par = 0; break;  case 2: kind = 2; par = 0; break;  case 3: kind = 3; par = 0; break;
            case 4: kind = 4; par = 0; break;  case 5: kind = 5; par = 0; break;  case 6: kind = 6; par = 0; break;
            case 7: kind = 3; par = 1; break;  case 8: kind = 1; par = 1; break;  case 9: kind = 2; par = 1; break;
            case 10: kind = 3; par = 2; break; case 11: kind = 1; par = 2; break; case 12: kind = 2; par = 2; break;
            case 13: kind = 3; par = 3; break; case 14: kind = 4; par = 1; break; case 15: kind = 7; par = 0; break;
            case 16: kind = 8; par = 0; break; case 17: kind = 9; par = 0; break; case 18: kind = 6; par = 1; break;
            case 19: kind = 3; par = 4; break; case 20: kind = 1; par = 3; break; case 21: kind = 2; par = 3; break;
            default: kind = 3; par = 5; break;
        }
        if (kind == 0 && EN0) {
            LAS float* scr = (LAS float*)(L + wave * 16384);
            constexpr int I_FI = 16 * 176, I_FO = 44 * 32, I_EIN = 16 * 80, I_EO = 16 * 32, I_OIN = 16 * 72, I_OO = 16 * 32;
            constexpr int NIT = 4 * I_FI + 4 * I_FO + I_EIN + I_EO + I_OIN + I_OO;
            for (int it = gw; it < NIT; it += NGW) {
                int r = it;
                if (r < 4 * I_FI) { const int f = r / I_FI; transpose_item(ffn_in + (size_t)f * D * NFF, D, NFF, (bf16*)(ws + WS_WFI + f * WFI_STRIDE), 1, scr, r % I_FI, lane); continue; } r -= 4 * I_FI;
                if (r < 4 * I_FO) { const int f = r / I_FO; transpose_item(ffn_out + (size_t)f * DFF * D, DFF, D, (bf16*)(ws + WS_WFO + f * WFO_STRIDE), 0, scr, r % I_FO, lane); continue; } r -= 4 * I_FO;
                if (r < I_EIN) { transpose_item(args.in[5], D, IN0, (bf16*)(ws + WS_EIN), 0, scr, r, lane); continue; } r -= I_EIN;
                if (r < I_EO) { transpose_item(args.in[10], D, D, (bf16*)(ws + WS_EOUT), 0, scr, r, lane); continue; } r -= I_EO;
                if (r < I_OIN) { transpose_item(args.in[11], D, IN1, (bf16*)(ws + WS_OIN), 0, scr, r, lane); continue; } r -= I_OIN;
                transpose_item(args.in[26], D, D, (bf16*)(ws + WS_OOUT), 0, scr, r, lane);
            }
            for (size_t i = ((size_t)bid * NTHR + tid) * 8; i < (size_t)M * D; i += (size_t)G * NTHR * 8) {
                const f32x4 a = *(const f32x4*)(x_in + i), c = *(const f32x4*)(x_in + i + 4);
                v4u o; o.x = pk2(a.x, a.y); o.y = pk2(a.z, a.w); o.z = pk2(c.x, c.y); o.w = pk2(c.z, c.w); *(v4u*)(XN + i) = o; }
        } else if (kind == 1 && EN1) {
            pg8::Gemm g{XN, (const bf16*)(ws + WS_WFI + par * WFI_STRIDE), M, NFF, D}; pg8::StaticOrder S; S.init(M, NFF, G, bid);
            pg8::EpiSwiglu E{H, DFF};
            pg8::gemm_phase<pg8::EpiSwiglu, pg8::StaticOrder, true, true>(L, g, S, E);
        } else if ((kind == 2 || kind == 6) && EN2) {
            pg8::Gemm g; pg8::EpiRes E;
            if (kind == 2) { g = pg8::Gemm{H, (const bf16*)(ws + WS_WFO + par * WFO_STRIDE), M, D, DFF}; E = pg8::EpiRes{par == 0 ? x_in : X, X, D, DN_ALPHA, 0.5f}; }
            else { g = pg8::Gemm{MIX, (const bf16*)(ws + (par == 0 ? WS_EOUT : WS_OOUT)), M, D, D}; E = pg8::EpiRes{X, X, D, DN_ALPHA, 1.0f}; }
            pg8::StaticOrder S; S.init(M, D, G, bid);
            pg8::gemm_phase<pg8::EpiRes, pg8::StaticOrder, true, true>(L, g, S, E);
        } else if (kind == 3 && EN3) {
            ln_phase(X, XN, ln_g + par * D, ln_b + par * D, par != 5, gw, NGW, lane);
        } else if (kind == 4 && EN4) {
            const int N = par == 0 ? IN0 : IN1;
            pg8::Gemm g{XN, (const bf16*)(ws + (par == 0 ? WS_EIN : WS_OIN)), M, N, D}; pg8::StaticOrder S; S.init(M, N, G, bid);
            pg8::EpiBf16<0> E{PB, N, nullptr, 0, 0, 1.f};
            pg8::gemm_phase<pg8::EpiBf16<0>, pg8::StaticOrder, true, true>(L, g, S, E);
        } else if (kind == 5 && EN5) {
            for (int u = bid; u < M / 32; u += G) conv_unit(PB, MIX, args.in[6], args.in[7], args.in[8], args.in[9], lf, u, tid, wave, lane);
            for (int u = gw; u < 4 * 8 * 256; u += NGW) attn_unit(PB, MIX, u, lane);
        } else if (kind == 7 && EN7) {
            OddW W{args.in[12], args.in[13], args.in[14], args.in[15], args.in[16], args.in[17], args.in[18], args.in[19], args.in[20], args.in[23], args.in[24], args.in[25]};
            for (int u = bid; u < M / 16; u += G) prep_unit(PB, W, Ar, Ae, Ak, Av, Akk, Ab, MIX, BON, lf, u, tid, wave, lane);
        } else if (kind == 8 && EN8) {
            for (int u = gw; u < 4 * 8 * 64; u += NGW) scan_unit(Ar, Ae, Ak, Av, Akk, Ab, Y, u, lane);
        } else if (kind == 9 && EN9) {
            post_phase(Y, Av, BON, MIX, args.in[21], args.in[22], bid, G, tid, wave, lane);
        }
    }
}

extern "C" void kernel_launch(void* const* d_in, const int* in_sizes, int n_in, void* d_out, int out_size, void* d_ws, size_t ws_size, hipStream_t stream) {
    static int grid = 0;
    if (grid == 0) {
        if (n_in != 27 || in_sizes[0] != M * D || out_size != M * D || ws_size < WS_END) { fprintf(stderr, "kernel_launch: unexpected shapes (n_in %d, in0 %d, out %d, ws %zu)\n", n_in, n_in > 0 ? in_sizes[0] : -1, out_size, ws_size); grid = -1; return; }
        int dev = 0, cus = 0, per_cu = 0;
        (void)hipGetDevice(&dev); (void)hipDeviceGetAttribute(&cus, hipDeviceAttributeMultiprocessorCount, dev);
        if (hipFuncSetAttribute((const void*)mega_fwd, hipFuncAttributeMaxDynamicSharedMemorySize, LDS_BYTES) != hipSuccess) { fprintf(stderr, "kernel_launch: hipFuncSetAttribute failed\n"); grid = -1; return; }
        if (hipOccupancyMaxActiveBlocksPerMultiprocessor(&per_cu, (const void*)mega_fwd, NTHR, LDS_BYTES) != hipSuccess || per_cu < 1) { fprintf(stderr, "kernel_launch: occupancy query gave %d\n", per_cu); per_cu = 1; }
        (void)hipGetLastError();
        grid = cus * per_cu;
        fprintf(stderr, "kernel_launch: grid %d (cus %d x %d)\n", grid, cus, per_cu);
    }
    if (grid < 0) return;
    Args a{};
    for (int i = 0; i < 27; ++i) a.in[i] = (const float*)d_in[i];
    a.out = (float*)d_out; a.ws = (unsigned char*)d_ws;
#if MK_N_LAUNCHES == 1
    a.ph_lo = 0; a.ph_hi = NPH;
    void* kargs[] = {&a};
    hipError_t e = hipLaunchCooperativeKernel((const void*)mega_fwd, dim3(grid), dim3(NTHR), kargs, LDS_BYTES, stream);
    if (e != hipSuccess) fprintf(stderr, "cooperative launch failed: %s (grid %d)\n", hipGetErrorString(e), grid);
#else
    for (int ph = 0; ph < NPH; ++ph) { a.ph_lo = ph; a.ph_hi = ph + 1; hipLaunchKernelGGL(mega_fwd, dim3(grid), dim3(NTHR), LDS_BYTES, stream, a); }
#endif
}
```

```cpp
#include <hip/hip_runtime.h>
#include <hip/hip_cooperative_groups.h>
#include <cstdio>
#include <cstdint>
namespace cg = cooperative_groups;
#ifndef MK_N_LAUNCHES
#define MK_N_LAUNCHES 1
#endif
namespace pg8 {
#define PG8_LAS __attribute__((address_space(3)))
typedef unsigned short bf16_t;
typedef short bf16x8 __attribute__((ext_vector_type(8)));
typedef float f32x4 __attribute__((ext_vector_type(4)));
typedef unsigned u32x4 __attribute__((ext_vector_type(4)));
constexpr int BM = 256, BK = 64, HALF = 128, HTB = HALF * BK * 2  , STAGE_BYTES = 8 * HTB, NXCD = 8, WGM = 8;

__host__ __device__ __forceinline__ int lds_byte(int r, int c) { const int st = (r >> 4) * 2 + (c >> 5), rr = r & 15, cc = c & 31, ob = rr * 64 + cc * 2; return st * 1024 + (ob ^ (((ob >> 9) & 1) << 5)); }
__host__ __device__ __forceinline__ void stage_rc(int b, int& R, int& C) { const int st = b / 1024, sb = b % 1024, swz = sb ^ (((sb >> 9) & 1) << 5); R = (st >> 1) * 16 + swz / 64; C = (st & 1) * 32 + (swz % 64) / 2; }
__host__ __device__ __forceinline__ int perm32(int rho) { const int n = rho >> 4, i = rho & 15; return 8 * (i >> 2) + 4 * n + (i & 3); }

struct Unit { int pm, pn; };
struct Gemm { const bf16_t* A; const bf16_t* Bt; int M, N, K; };

struct StaticOrder {
    int nM, nN, nwg, G, c;
    __host__ __device__ void init(int M, int N, int G_, int c_) { nM = M / BM; nN = N / BM; nwg = nM * nN; G = G_; c = c_; }
    __host__ __device__ bool next(int i, Unit& u) const {
        const long L = (long)i * G + c; if (L >= nwg) return false;
        int wgid = (int)L; { const int q = nwg / NXCD, r = nwg % NXCD, xcd = wgid % NXCD, off = wgid / NXCD; wgid = (xcd < r ? xcd * (q + 1) : r * (q + 1) + (xcd - r) * q) + off; }
        const int nig = WGM * nN, gid = wgid / nig, fm = gid * WGM, gsz = (nM - fm) < WGM ? (nM - fm) : WGM;
        u.pm = fm + ((wgid % nig) % gsz); u.pn = (wgid % nig) / gsz; return true;
    }
    __device__ __forceinline__ void a_ready(const Unit&) const {}
    __device__ __forceinline__ void done(const Unit&) const {}
};

__device__ __forceinline__ unsigned cvt_pk_bf16(float lo, float hi) { unsigned r; asm volatile("v_cvt_pk_bf16_f32 %0, %1, %2" : "=v"(r) : "v"(lo), "v"(hi)); return r; }
typedef float f32x2 __attribute__((ext_vector_type(2)));
__device__ __forceinline__ f32x2 gelu_pk(f32x2 v) {
    const f32x2 av = __builtin_elementwise_abs(v), d = av * 0.2316418882f + 1.0f;
    f32x2 t; t.x = __builtin_amdgcn_rcpf(d.x); t.y = __builtin_amdgcn_rcpf(d.y);
    f32x2 q = t * 0.5307027145f + (-0.7265760135f); q = q * t + 0.7107068705f; q = q * t + (-0.142248368f); q = q * t + 0.127414796f; q = q * t;
    const f32x2 s = (v * v) * (-0.72134752044f);
    f32x2 e; e.x = __builtin_amdgcn_exp2f(s.x); e.y = __builtin_amdgcn_exp2f(s.y);
    const f32x2 m = v * (q * e), r = v - m;
    f32x2 o; o.x = v.x < 0.f ? m.x : r.x; o.y = v.y < 0.f ? m.y : r.y; return o;
}

template <int ACT  > struct EpiBf16 {
    static constexpr bool PERM = true, AFTER_DRAIN = false; static_assert(ACT == 0 || ACT == 1, "EpiBf16: ACT is 0 (none) or 1 (gelu_pk)");
    bf16_t* O; int ldc; const float* bias; int split_cols; size_t split_stride; float scale0;
    __device__ __forceinline__ void operator()(const f32x4 (&acc)[2][2][4][2], const Unit& u, int wr, int wc, int fr, int fq) const {
        const int row0 = u.pm * BM + wr * 64 + fr; int colt = u.pn * BM; bf16_t* base = O;
        float sc = 1.f; if (split_cols) { const int t = colt / split_cols; base += (size_t)t * split_stride; colt -= t * split_cols; if (t == 0) sc = scale0; }
        const int col0 = colt + wc * 32 + 8 * fq, bcol0 = u.pn * BM + wc * 32 + 8 * fq;
        f32x4 bv[2][2];
#pragma unroll
        for (int bj = 0; bj < 2; ++bj)
#pragma unroll
            for (int n = 0; n < 2; ++n) bv[bj][n] = bias ? *(const f32x4*)(bias + bcol0 + bj * HALF + 4 * n) : (f32x4){0.f, 0.f, 0.f, 0.f};
#pragma unroll
        for (int ai = 0; ai < 2; ++ai)
#pragma unroll
            for (int m = 0; m < 4; ++m) { bf16_t* rowp = base + (size_t)(row0 + ai * HALF + m * 16) * ldc + col0;
#pragma unroll
                for (int bj = 0; bj < 2; ++bj) { f32x4 v0 = acc[ai][bj][m][0] + bv[bj][0], v1 = acc[ai][bj][m][1] + bv[bj][1];
                    if (ACT == 1) { f32x2 a = gelu_pk((f32x2){v0[0], v0[1]}), b = gelu_pk((f32x2){v0[2], v0[3]}), c = gelu_pk((f32x2){v1[0], v1[1]}), d = gelu_pk((f32x2){v1[2], v1[3]});
                        v0 = (f32x4){a.x, a.y, b.x, b.y}; v1 = (f32x4){c.x, c.y, d.x, d.y}; }
                    v0 = v0 * sc; v1 = v1 * sc; u32x4 w; w.x = cvt_pk_bf16(v0[0], v0[1]); w.y = cvt_pk_bf16(v0[2], v0[3]); w.z = cvt_pk_bf16(v1[0], v1[1]); w.w = cvt_pk_bf16(v1[2], v1[3]);
                    *(u32x4*)(rowp + bj * HALF) = w; } }
    }
};
struct EpiSwiglu {
    static constexpr bool PERM = true, AFTER_DRAIN = false;
    bf16_t* O; int ldc;
    __device__ __forceinline__ void operator()(const f32x4 (&acc)[2][2][4][2], const Unit& u, int wr, int wc, int fr, int fq) const {
        const int row0 = u.pm * BM + wr * 64 + fr, col0 = u.pn * HALF + wc * 32 + 8 * fq;
#pragma unroll
        for (int ai = 0; ai < 2; ++ai)
#pragma unroll
            for (int m = 0; m < 4; ++m) { bf16_t* rowp = O + (size_t)(row0 + ai * HALF + m * 16) * ldc + col0;
                float hv[8];
#pragma unroll
                for (int n = 0; n < 2; ++n)
#pragma unroll
                    for (int e = 0; e < 4; ++e) { const float g = acc[ai][0][m][n][e], up = acc[ai][1][m][n][e]; hv[n * 4 + e] = g * up * __builtin_amdgcn_rcpf(1.0f + __expf(-g)); }
                u32x4 w; w.x = cvt_pk_bf16(hv[0], hv[1]); w.y = cvt_pk_bf16(hv[2], hv[3]); w.z = cvt_pk_bf16(hv[4], hv[5]); w.w = cvt_pk_bf16(hv[6], hv[7]);
                *(u32x4*)rowp = w; }
    }
};
struct EpiRes {
    static constexpr bool PERM = false, AFTER_DRAIN = false;
    const float* base; float* out; int ldc; float alpha, s;
    __device__ __forceinline__ void operator()(const f32x4 (&acc)[2][2][4][2], const Unit& u, int wr, int wc, int fr, int fq) const {
        const int col0 = u.pn * BM + wc * 32 + 4 * fq;
#pragma unroll
        for (int ai = 0; ai < 2; ++ai)
#pragma unroll
            for (int m = 0; m < 4; ++m) { const int r = u.pm * BM + ai * HALF + wr * 64 + m * 16 + fr; const size_t off = (size_t)r * ldc + col0;
#pragma unroll
                for (int bj = 0; bj < 2; ++bj)
#pragma unroll
                    for (int n = 0; n < 2; ++n) { const f32x4 bs = *(const f32x4*)(base + off + bj * HALF + n * 16); const f32x4 o = bs * alpha + acc[ai][bj][m][n] * s; *(f32x4*)(out + off + bj * HALF + n * 16) = o; } }
    }
};

template <class Epi, class Sched, bool ALIGN_EPI = false, bool SP2 = false>
__device__ __forceinline__ void gemm_phase(PG8_LAS unsigned char* lds, const Gemm g, const Sched& S, const Epi& E) {
    const int tid = threadIdx.x, wid = __builtin_amdgcn_readfirstlane(tid >> 6), lane = tid & 63, wr = wid >> 2, wc = wid & 3, fr = lane & 15, fq = lane >> 4;
    const int K = g.K, nt = K / BK;
    unsigned voffA[2], voffB[2];
#pragma unroll
    for (int i = 0; i < 2; ++i) { int R, C; stage_rc(tid * 16 + i * 8192, R, C); const int Rb = Epi::PERM ? ((R & ~31) + perm32(R & 31)) : R;
        voffA[i] = (unsigned)(R * K + C) * 2u; voffB[i] = (unsigned)(Rb * K + C) * 2u; }
    const size_t kstep = (size_t)(BK * 2);
    const size_t hstep = (size_t)HALF * K * 2;
    const size_t tstep = 2 * hstep;
    const unsigned ldsw = (unsigned)wid * 1024u;
    const int aoff = lds_byte(wr * 64 + fr, fq * 8), boff = lds_byte(wc * 32 + fr, fq * 8);
#define PG8_SA(b, h) (((b) * 2 + (h)) * HTB)
#define PG8_SB(b, h) ((4 + (b) * 2 + (h)) * HTB)
#define PG8_STAGE(bufoff, gbase, voff) do { _Pragma("unroll") for (int _i = 0; _i < 2; ++_i) \
        __builtin_amdgcn_global_load_lds((const unsigned*)((const char*)(gbase) + (voff)[_i]), (PG8_LAS unsigned*)(lds + (bufoff) + ldsw + _i * 8192), 16, 0, 0); } while (0)
#define PG8_LDA(dst, b, h) do { _Pragma("unroll") for (int m = 0; m < 4; ++m) _Pragma("unroll") for (int k = 0; k < 2; ++k) dst[m][k] = *(const PG8_LAS bf16x8*)(lds + PG8_SA(b, h) + aoff + m * 2048 + k * 1024); } while (0)
#define PG8_LDB(dst, b, h) do { _Pragma("unroll") for (int n = 0; n < 2; ++n) _Pragma("unroll") for (int k = 0; k < 2; ++k) dst[n][k] = *(const PG8_LAS bf16x8*)(lds + PG8_SB(b, h) + boff + n * 2048 + k * 1024); } while (0)
#define PG8_MMA(ai, bj, At, Bt) do { __builtin_amdgcn_s_setprio(1); _Pragma("unroll") for (int m = 0; m < 4; ++m) _Pragma("unroll") for (int n = 0; n < 2; ++n) _Pragma("unroll") for (int k = 0; k < 2; ++k) \
        acc[ai][bj][m][n] = __builtin_amdgcn_mfma_f32_16x16x32_bf16(Bt[n][k], At[m][k], acc[ai][bj][m][n], 0, 0, 0); __builtin_amdgcn_s_setprio(0); } while (0)
#define PG8_WAIT_V(n) asm volatile("s_waitcnt vmcnt(" #n ")" ::: "memory")
#define PG8_WAIT_L(n) asm volatile("s_waitcnt lgkmcnt(" #n ")" ::: "memory")
#define PG8_BAR __builtin_amdgcn_s_barrier()
#define PG8_SCHED __builtin_amdgcn_sched_barrier(0)
    Unit cur, nxt; int ui = 0;
    if (!S.next(0, cur)) return;
    f32x4 acc[2][2][4][2];
#pragma unroll
    for (int a = 0; a < 2; ++a)
#pragma unroll
        for (int b = 0; b < 2; ++b)
#pragma unroll
            for (int m = 0; m < 4; ++m)
#pragma unroll
                for (int n = 0; n < 2; ++n) acc[a][b][m][n] = (f32x4){0.f, 0.f, 0.f, 0.f};
    bf16x8 At[4][2], B0[2][2], B1[2][2];
    const char* cA = (const char*)g.A + (size_t)cur.pm * tstep; const char* cB = (const char*)g.Bt + (size_t)cur.pn * tstep;
    S.a_ready(cur);
    if constexpr (SP2) {
        PG8_STAGE(PG8_SB(0, 0), cB, voffB); PG8_STAGE(PG8_SB(0, 1), cB + hstep, voffB); PG8_STAGE(PG8_SA(0, 0), cA, voffA); PG8_STAGE(PG8_SA(0, 1), cA + hstep, voffA);
        if (wr == 1) PG8_BAR;
        PG8_WAIT_V(2); PG8_BAR;
        PG8_STAGE(PG8_SB(1, 0), cB + kstep, voffB); PG8_STAGE(PG8_SA(1, 0), cA + kstep, voffA); PG8_STAGE(PG8_SB(1, 1), cB + hstep + kstep, voffB);
        PG8_WAIT_V(6); PG8_BAR;
    } else {
        PG8_STAGE(PG8_SB(0, 0), cB, voffB); PG8_STAGE(PG8_SA(0, 0), cA, voffA); PG8_STAGE(PG8_SB(0, 1), cB + hstep, voffB); PG8_STAGE(PG8_SA(0, 1), cA + hstep, voffA);
        if (wr == 1) PG8_BAR;
        PG8_WAIT_V(4); PG8_BAR;
        PG8_STAGE(PG8_SB(1, 0), cB + kstep, voffB); PG8_STAGE(PG8_SA(1, 0), cA + kstep, voffA); PG8_STAGE(PG8_SB(1, 1), cB + hstep + kstep, voffB);
        PG8_WAIT_V(6); PG8_BAR;
    }
    for (;;) {
        const bool has_next = S.next(ui + 1, nxt);
        const char* nA = has_next ? (const char*)g.A + (size_t)nxt.pm * tstep : cA; const char* nB = has_next ? (const char*)g.Bt + (size_t)nxt.pn * tstep : cB;
        for (int t = 0; t < nt; t += 2) {
            const bool last = (t == nt - 2);
            const char* a1 = cA + (size_t)(t + 1) * kstep;
            const char* a2 = last ? nA : cA + (size_t)(t + 2) * kstep; const char* b2 = last ? nB : cB + (size_t)(t + 2) * kstep;
            const char* a3 = a2 + kstep; const char* b3 = b2 + kstep;
            if (last && has_next) S.a_ready(nxt);
            if constexpr (SP2) {
            PG8_LDB(B0, 0, 0); PG8_LDB(B1, 0, 1); PG8_SCHED; PG8_LDA(At, 0, 0); PG8_STAGE(PG8_SA(1, 1), a1 + hstep, voffA);
            PG8_WAIT_V(8); PG8_WAIT_L(0); PG8_BAR; PG8_MMA(0, 0, At, B0); PG8_MMA(0, 1, At, B1); PG8_BAR; PG8_SCHED;
            PG8_LDA(At, 0, 1); PG8_STAGE(PG8_SB(0, 0), b2, voffB); PG8_STAGE(PG8_SB(0, 1), b2 + hstep, voffB); PG8_STAGE(PG8_SA(0, 0), a2, voffA);
            PG8_WAIT_V(8); PG8_WAIT_L(0); PG8_BAR; PG8_MMA(1, 0, At, B0); PG8_MMA(1, 1, At, B1); PG8_BAR; PG8_SCHED;
            PG8_LDB(B0, 1, 0); PG8_LDB(B1, 1, 1); PG8_SCHED; PG8_LDA(At, 1, 0); PG8_STAGE(PG8_SA(0, 1), a2 + hstep, voffA);
            PG8_WAIT_V(8); PG8_WAIT_L(0); PG8_BAR; PG8_MMA(0, 0, At, B0); PG8_MMA(0, 1, At, B1); PG8_BAR; PG8_SCHED;
            PG8_LDA(At, 1, 1); PG8_STAGE(PG8_SB(1, 0), b3, voffB); PG8_STAGE(PG8_SB(1, 1), b3 + hstep, voffB); PG8_STAGE(PG8_SA(1, 0), a3, voffA);
            PG8_WAIT_V(8); PG8_WAIT_L(0); PG8_BAR; PG8_MMA(1, 0, At, B0); PG8_MMA(1, 1, At, B1); PG8_BAR; PG8_SCHED;
            } else {
            PG8_LDB(B0, 0, 0); PG8_SCHED; PG8_LDA(At, 0, 0); PG8_STAGE(PG8_SA(1, 1), a1 + hstep, voffA);
            PG8_WAIT_L(8); PG8_BAR; PG8_WAIT_L(0); PG8_MMA(0, 0, At, B0); PG8_BAR; PG8_SCHED;
            PG8_LDB(B1, 0, 1); PG8_STAGE(PG8_SB(0, 0), b2, voffB);
            PG8_BAR; PG8_WAIT_L(0); PG8_MMA(0, 1, At, B1); PG8_BAR;
            PG8_LDA(At, 0, 1); PG8_STAGE(PG8_SA(0, 0), a2, voffA);
            PG8_BAR; PG8_WAIT_L(0); PG8_MMA(1, 0, At, B0); PG8_BAR; PG8_SCHED;
            PG8_STAGE(PG8_SB(0, 1), b2 + hstep, voffB);
            PG8_WAIT_V(6); PG8_BAR; PG8_MMA(1, 1, At, B1); PG8_BAR;
            PG8_LDB(B0, 1, 0); PG8_SCHED; PG8_LDA(At, 1, 0); PG8_STAGE(PG8_SA(0, 1), a2 + hstep, voffA);
            PG8_WAIT_L(8); PG8_BAR; PG8_WAIT_L(0); PG8_MMA(0, 0, At, B0); PG8_BAR; PG8_SCHED;
            PG8_LDB(B1, 1, 1); PG8_STAGE(PG8_SB(1, 0), b3, voffB);
            PG8_BAR; PG8_WAIT_L(0); PG8_MMA(0, 1, At, B1); PG8_BAR;
            PG8_LDA(At, 1, 1); PG8_STAGE(PG8_SA(1, 0), a3, voffA);
            PG8_BAR; PG8_WAIT_L(0); PG8_MMA(1, 0, At, B0); PG8_BAR; PG8_SCHED;
            PG8_STAGE(PG8_SB(1, 1), b3 + hstep, voffB);
            PG8_WAIT_V(6); PG8_BAR; PG8_MMA(1, 1, At, B1); PG8_BAR;
            }
        }
        if constexpr (ALIGN_EPI) { if (wr == 0) PG8_BAR; }
        if constexpr (!Epi::AFTER_DRAIN) { E(acc, cur, wr, wc, fr, fq); S.done(cur); }
        if (!has_next) break;
#pragma unroll
        for (int a = 0; a < 2; ++a)
#pragma unroll
            for (int b = 0; b < 2; ++b)
#pragma unroll
                for (int m = 0; m < 4; ++m)
#pragma unroll
                    for (int n = 0; n < 2; ++n) acc[a][b][m][n] = (f32x4){0.f, 0.f, 0.f, 0.f};
        cur = nxt; cA = nA; cB = nB; ++ui;
        if constexpr (ALIGN_EPI) { if (wr == 1) PG8_BAR; }
    }
    PG8_WAIT_V(0);
    if constexpr (!ALIGN_EPI) { if (wr == 0) PG8_BAR; }
    PG8_BAR;
    if constexpr (Epi::AFTER_DRAIN) { E.fused(acc, cur, wr, wc, fr, fq, lds, wid, lane); S.done(cur); }
#undef PG8_SA
#undef PG8_SB
#undef PG8_STAGE
#undef PG8_LDA
#undef PG8_LDB
#undef PG8_MMA
#undef PG8_WAIT_V
#undef PG8_WAIT_L
#undef PG8_BAR
#undef PG8_SCHED
}
}
#define LAS __attribute__((address_space(3)))
typedef unsigned short bf16;
typedef float f32x4 __attribute__((ext_vector_type(4)));
typedef float f32x16 __attribute__((ext_vector_type(16)));
typedef short bf16x8 __attribute__((ext_vector_type(8)));
typedef unsigned v4u __attribute__((ext_vector_type(4)));
typedef unsigned v2u __attribute__((ext_vector_type(2)));
constexpr int NWAVES = 8, NTHR = 512;
constexpr int M = 32768, SEQ = 8192, D = 1024, DFF = 2816, NFF = 5632, IN0 = 2560, IN1 = 2304, RWD = 512;
constexpr float DN_ALPHA = 1.41421356237f, LN_EPS = 1e-5f, GN_EPS = 64e-5f;
constexpr size_t MiB = 1u << 20;
constexpr size_t WS_WFI = 1 * MiB, WFI_STRIDE = 11 * MiB;
constexpr size_t WS_WFO = 45 * MiB, WFO_STRIDE = 11 * MiB / 2;
constexpr size_t WS_EIN = 67 * MiB, WS_EOUT = 72 * MiB, WS_OIN = 74 * MiB, WS_OOUT = 78 * MiB + 512 * 1024;
constexpr size_t WS_XN = 90 * MiB;
constexpr size_t WS_H = 154 * MiB;
constexpr size_t WS_ARR = 298 * MiB;
constexpr size_t WS_MIX = 426 * MiB;
constexpr size_t WS_BON = 490 * MiB;
constexpr size_t WS_END = 492 * MiB;
constexpr int LDS_BYTES = 147456;
#define XB_TMO      128
#define XB_XCNT(j)  (256  + 64 * (j))
#define XB_XSUB(j)  (1280 + 64 * (j))
#define XB_XGEN(j)  (2304 + 64 * (j))
#define XB_TOP      3328
#define XB_TOPGEN   3392
#define XCD_BAR_WORDS 3456
#define XB_SPIN_CAP (1u << 18)

__device__ __forceinline__ unsigned xb_ld(unsigned* p)              { return __hip_atomic_load(p, __ATOMIC_RELAXED, __HIP_MEMORY_SCOPE_AGENT); }
__device__ __forceinline__ unsigned xb_add(unsigned* p, unsigned v) { return __hip_atomic_fetch_add(p, v, __ATOMIC_RELAXED, __HIP_MEMORY_SCOPE_AGENT); }
__device__ __forceinline__ unsigned xb_xcc_id() { return (unsigned)__builtin_amdgcn_s_getreg((3 << 11) | 20) & 0xFu; }
#define XB_SPIN(cond, bar) do { unsigned _sp = 0; while (cond) { __builtin_amdgcn_s_sleep(1); \
    if ((++_sp & 255u) == 0u) { if (xb_ld(&(bar)[XB_TMO])) break; if (_sp > XB_SPIN_CAP) { atomicAdd(&(bar)[XB_TMO], 1u); break; } } } } while (0)

struct XcdBarrier {
    unsigned* bar; unsigned x;
    volatile LAS unsigned* st;
};

__device__ __forceinline__ XcdBarrier xcd_barrier_post(unsigned* bar, volatile LAS unsigned* st) {
    XcdBarrier b; b.bar = bar; b.x = xb_xcc_id(); b.st = st;
    if (threadIdx.x == 0) (void)xb_add(&bar[XB_XCNT(b.x)], 1u);
    return b;
}
__device__ __forceinline__ void xcd_barrier_complete(unsigned* bar, unsigned x, unsigned& nloc, unsigned& nx) {
    const unsigned G = gridDim.x * gridDim.y * gridDim.z;
    unsigned sum, cnt, mine, sp = 0u;
    for (;;) {
        sum = 0u; cnt = 0u; mine = 0u;
#pragma unroll
        for (unsigned j = 0; j < 16; ++j) { const unsigned c = xb_ld(&bar[XB_XCNT(j)]); sum += c; cnt += (c > 0u) ? 1u : 0u; mine = (j == x) ? c : mine; }
        if (sum == G) break;
        __builtin_amdgcn_s_sleep(1);
        if ((++sp & 255u) == 0u) { if (xb_ld(&bar[XB_TMO])) break; if (sp > XB_SPIN_CAP) { atomicAdd(&bar[XB_TMO], 1u); break; } }
    }
    nloc = mine > 0u ? mine : 1u; nx = cnt > 0u ? cnt : 1u;
}

__device__ __forceinline__ void xcd_barrier(const XcdBarrier& b) {
    asm volatile("s_waitcnt vmcnt(0)" ::: "memory");
    __syncthreads();
    if (threadIdx.x == 0) {
        unsigned* bar = b.bar;
        __builtin_amdgcn_s_waitcnt(0);
        unsigned nloc = b.st[0], nx = b.st[1];
        if (nloc == 0u) { xcd_barrier_complete(bar, b.x, nloc, nx); b.st[0] = nloc; b.st[1] = nx; }
        const unsigned old = xb_add(&bar[XB_XSUB(b.x)], 1u);
        const unsigned gen = old / nloc;
        if (old + 1u == (gen + 1u) * nloc) {
            __builtin_amdgcn_fence(__ATOMIC_RELEASE, "agent");
            asm volatile("s_waitcnt vmcnt(0)" ::: "memory");
            const unsigned og = xb_add(&bar[XB_TOP], 1u);
            const unsigned tg = og / nx;
            if (og + 1u == (tg + 1u) * nx) xb_add(&bar[XB_TOPGEN], 1u);
            else XB_SPIN(xb_ld(&bar[XB_TOPGEN]) == tg, bar);
            __builtin_amdgcn_fence(__ATOMIC_ACQUIRE, "agent");
            xb_add(&bar[XB_XGEN(b.x)], 1u);
            asm volatile("s_waitcnt vmcnt(0)" ::: "memory");
        } else {
            XB_SPIN(xb_ld(&bar[XB_XGEN(b.x)]) == gen, bar);
            __builtin_amdgcn_fence(__ATOMIC_ACQUIRE, "agent");
            asm volatile("s_waitcnt vmcnt(0)" ::: "memory");
        }
    }
    __syncthreads();
}

#ifndef PROBE_LN
#define PROBE_LN 0
#endif
#ifndef PROBE_SYNC
#define PROBE_SYNC 0
#endif
#ifndef DUP_PH
#define DUP_PH -1
#define DUP_N 0
#endif
constexpr int NPH = 23 + DUP_N;

__device__ __forceinline__ float bf2f(bf16 v) { return __uint_as_float((unsigned)v << 16); }
__device__ __forceinline__ unsigned f2bf(float f) { unsigned u = __float_as_uint(f); return (u + 0x7fffu + ((u >> 16) & 1u)) >> 16; }
__device__ __forceinline__ unsigned pk2(float lo, float hi) { return f2bf(lo) | (f2bf(hi) << 16); }
__device__ __forceinline__ float wave_sum(float v) {
#pragma unroll
    for (int o = 1; o < 64; o <<= 1) v += __shfl_xor(v, o);
    return v;
}
__device__ __forceinline__ float sigmoidf_(float x) { return 1.0f / (1.0f + __expf(-x)); }
__device__ __forceinline__ float softplusf_(float x) { return fmaxf(x, 0.f) + __logf(1.0f + __expf(-fabsf(x))); }

struct Args { const float* in[27]; float* out; unsigned char* ws; int ph_lo, ph_hi; };

__device__ __forceinline__ void transpose_item(const float* W, int K, int N, bf16* WT, int mode, LAS float* scr, int item, int lane) {
    const int nblk = N / 32, kb = item / nblk, nb = item % nblk, k0 = 64 * kb, n0 = 32 * nb;
    int d0 = n0;
    if (mode == 1) { if (n0 < DFF) d0 = (n0 >> 7) * 256 + (n0 & 127); else { const int n2 = n0 - DFF; d0 = (n2 >> 7) * 256 + 128 + (n2 & 127); } }
#pragma unroll 8
    for (int i = 0; i < 32; ++i) { const int kk = 2 * i + (lane >> 5); scr[kk * 33 + (lane & 31)] = W[(size_t)(k0 + kk) * N + n0 + (lane & 31)]; }
    asm volatile("s_waitcnt lgkmcnt(0)" ::: "memory");
    const int c = lane & 7;
#pragma unroll
    for (int j = 0; j < 4; ++j) { const int n = (lane >> 3) + 8 * j; const LAS float* s = scr + (8 * c) * 33 + n;
        v4u o; o.x = pk2(s[0 * 33], s[1 * 33]); o.y = pk2(s[2 * 33], s[3 * 33]); o.z = pk2(s[4 * 33], s[5 * 33]); o.w = pk2(s[6 * 33], s[7 * 33]);
        *(v4u*)(WT + (size_t)(d0 + n) * K + k0 + 8 * c) = o; }
    asm volatile("s_waitcnt lgkmcnt(0)" ::: "memory");
}

__device__ __forceinline__ void ln_phase(const float* Xi, float* X, bf16* XN, const float* g, const float* b, bool write_xn, int gw, int NGW, int lane) {
    for (int m = gw; m < M; m += NGW) {
        f32x4* xr = (f32x4*)(X + (size_t)m * D) + lane; const f32x4* xi = (const f32x4*)(Xi + (size_t)m * D) + lane;
        f32x4 v[4]; float s = 0.f;
#pragma unroll
        for (int j = 0; j < 4; ++j) { v[j] = xi[64 * j]; s += (v[j].x + v[j].y) + (v[j].z + v[j].w); }
        const float mean = wave_sum(s) * (1.f / D); float s2 = 0.f;
#pragma unroll
        for (int j = 0; j < 4; ++j) { v[j] = v[j] - mean; s2 += (v[j].x * v[j].x + v[j].y * v[j].y) + (v[j].z * v[j].z + v[j].w * v[j].w); }
        const float rstd = rsqrtf(wave_sum(s2) * (1.f / D) + LN_EPS);
        v2u* o8 = (v2u*)(XN + (size_t)m * D) + lane;
#pragma unroll
        for (int j = 0; j < 4; ++j) { const f32x4 gg = ((const f32x4*)g)[lane + 64 * j], bb = ((const f32x4*)b)[lane + 64 * j]; const f32x4 o = v[j] * rstd * gg + bb; xr[64 * j] = o;
            if (write_xn) { v2u w; w.x = pk2(o.x, o.y); w.y = pk2(o.z, o.w); o8[64 * j] = w; } }
    }
}

__device__ __forceinline__ void conv_unit(const bf16* P0, bf16* MIX, const float* wdw, const float* bdw, const float* cgam, const float* cbet, LAS float* lf, int unit, int tid, int wave, int lane) {
    const int t0g = unit * 32, tseq0 = t0g & (SEQ - 1);
    float h[62];
#pragma unroll
    for (int i = 0; i < 62; ++i) { float val = 0.f;
        if (tseq0 - 30 + i >= 0) { const size_t row = (size_t)(t0g - 30 + i); const float a = bf2f(P0[row * IN0 + tid]), g = bf2f(P0[row * IN0 + 512 + tid]); val = a * sigmoidf_(g); }
        h[i] = val; }
    float acc[32]; const float bias = bdw[tid];
#pragma unroll
    for (int tt = 0; tt < 32; ++tt) acc[tt] = bias;
#pragma unroll
    for (int j = 0; j < 31; ++j) { const float w = wdw[j * 512 + tid];
#pragma unroll
        for (int tt = 0; tt < 32; ++tt) acc[tt] = fmaf(w, h[tt + j], acc[tt]); }
#pragma unroll
    for (int tt = 0; tt < 32; ++tt) lf[tt * 512 + tid] = acc[tt];
    __syncthreads();
#pragma unroll 1
    for (int q = 0; q < 4; ++q) { const int tt = wave * 4 + q; float v[8]; float s = 0.f;
#pragma unroll
        for (int k = 0; k < 8; ++k) { v[k] = lf[tt * 512 + lane + 64 * k]; s += v[k]; }
        const float mean = wave_sum(s) * (1.f / 512.f); float s2 = 0.f;
#pragma unroll
        for (int k = 0; k < 8; ++k) { v[k] -= mean; s2 += v[k] * v[k]; }
        const float rstd = rsqrtf(wave_sum(s2) * (1.f / 512.f) + LN_EPS);
#pragma unroll
        for (int k = 0; k < 8; ++k) { const int c = lane + 64 * k; float y = v[k] * rstd * cgam[c] + cbet[c]; y = y * sigmoidf_(y); MIX[(size_t)(t0g + tt) * D + c] = (bf16)f2bf(y); } }
    __syncthreads();
}

__device__ __forceinline__ int crow(int reg, int h) { return (reg & 3) + 8 * (reg >> 2) + 4 * h; }
__device__ __forceinline__ void attn_unit(const bf16* P0, bf16* MIX, int u, int lane) {
    const int b = u >> 11, hd = (u >> 8) & 7, qb = u & 255;
    const int r = lane & 31, hh = lane >> 5;
    const size_t rowb = (size_t)b * SEQ;
    const bf16* Qp = P0 + (rowb + qb * 32 + r) * IN0 + 1024 + hd * 64 + 8 * hh;
    bf16x8 qf[4];
#pragma unroll
    for (int c = 0; c < 4; ++c) qf[c] = *(const bf16x8*)(Qp + 16 * c);
    f32x16 o0, o1;
#pragma unroll
    for (int i = 0; i < 16; ++i) { o0[i] = 0.f; o1[i] = 0.f; }
    float R = 0.f;
    for (int kt = qb; kt >= 0; --kt) {
        const bf16* Kp = P0 + (rowb + kt * 32 + r) * IN0 + 1536 + hd * 64 + 8 * hh;
        f32x16 x;
#pragma unroll
        for (int i = 0; i < 16; ++i) x[i] = 0.f;
#pragma unroll
        for (int c = 0; c < 4; ++c) { const bf16x8 kf = *(const bf16x8*)(Kp + 16 * c); x = __builtin_amdgcn_mfma_f32_32x32x16_bf16(kf, qf[c], x, 0, 0, 0); }
        const bool diag = (kt == qb);
        float sp[16], z[16];
#pragma unroll
        for (int i = 0; i < 16; ++i) { z[i] = x[i] * 0.125f; const bool valid = !diag || (crow(i, hh) < r); sp[i] = valid ? softplusf_(z[i]) : 0.f; }
        float T[4], PT[4];
#pragma unroll
        for (int g = 0; g < 4; ++g) { sp[4 * g + 2] += sp[4 * g + 3]; sp[4 * g + 1] += sp[4 * g + 2]; sp[4 * g] += sp[4 * g + 1]; T[g] = sp[4 * g]; }
#pragma unroll
        for (int g = 0; g < 4; ++g) PT[g] = __shfl_xor(T[g], 32);
        float after[4]; float own = 0.f, part = 0.f;
#pragma unroll
        for (int g = 3; g >= 0; --g) { const float pincl = part + PT[g]; after[g] = own + (hh == 0 ? pincl : part); own += T[g]; part = pincl; }
        float p[16];
#pragma unroll
        for (int i = 0; i < 16; ++i) { const bool valid = !diag || (crow(i, hh) < r); const float cs = sp[i] + after[i >> 2] + R; p[i] = valid ? __expf(z[i] - cs) : 0.f; }
        R += own + part;
#pragma unroll
        for (int s = 0; s < 2; ++s) {
            v4u pw; pw.x = pk2(p[8 * s], p[8 * s + 1]); pw.y = pk2(p[8 * s + 2], p[8 * s + 3]); pw.z = pk2(p[8 * s + 4], p[8 * s + 5]); pw.w = pk2(p[8 * s + 6], p[8 * s + 7]);
            const bf16x8 pf = __builtin_bit_cast(bf16x8, pw);
            bf16x8 v0, v1;
#pragma unroll
            for (int j = 0; j < 8; ++j) { const int key = kt * 32 + 16 * s + 8 * (j >> 2) + 4 * hh + (j & 3); const bf16* vp = P0 + (rowb + key) * IN0 + 2048 + hd * 64 + r; v0[j] = (short)vp[0]; v1[j] = (short)vp[32]; }
            o0 = __builtin_amdgcn_mfma_f32_32x32x16_bf16(v0, pf, o0, 0, 0, 0);
            o1 = __builtin_amdgcn_mfma_f32_32x32x16_bf16(v1, pf, o1, 0, 0, 0);
        }
        if (__all(R > 44.5f)) break;
    }
    bf16* Op = MIX + (rowb + qb * 32 + r) * D + 512 + hd * 64 + 4 * hh;
#pragma unroll
    for (int g = 0; g < 4; ++g) {
        v2u w0; w0.x = pk2(o0[4 * g], o0[4 * g + 1]); w0.y = pk2(o0[4 * g + 2], o0[4 * g + 3]); *(v2u*)(Op + 8 * g) = w0;
        v2u w1; w1.x = pk2(o1[4 * g], o1[4 * g + 1]); w1.y = pk2(o1[4 * g + 2], o1[4 * g + 3]); *(v2u*)(Op + 32 + 8 * g) = w1;
    }
}

struct OddW { const float *mu, *w0, *w2, *a0, *a2, *g2, *k_k, *k_a, *r_k, *wpool, *bpool, *pscale; };
__device__ __forceinline__ void prep_unit(const bf16* P1, const OddW& W, bf16* Ar, bf16* Ae, bf16* Ak, bf16* Av, bf16* Akk, bf16* Ab, bf16* MIX, float* BON, LAS float* lf, int unit, int tid, int wave, int lane) {
    LAS float* lora = lf;
    LAS float* pooled = lf + 4096;
    const int t0g = unit * 16, tseq0 = t0g & (SEQ - 1);
#pragma unroll
    for (int k = 0; k < 8; ++k) { const int idx = tid + 512 * k, tok = idx >> 8, i = idx & 255; const size_t row = (size_t)(t0g + tok);
        const float cur = bf2f(P1[row * IN1 + 1536 + i]); const float prev = (tseq0 + tok > 0) ? bf2f(P1[(row - 1) * IN1 + 1536 + i]) : 0.f;
        const float x = cur + (prev - cur) * W.mu[1536 + i];
        lora[idx] = (i < 64) ? tanhf(x) : ((i < 128) ? x : sigmoidf_(x)); }
    const int grp = tid >> 7, win = 2 << grp;
    {
        float arr[31];
#pragma unroll
        for (int i = 0; i < 31; ++i) arr[i] = (tseq0 - 15 + i >= 0) ? bf2f(P1[(size_t)(t0g - 15 + i) * IN1 + 1792 + tid]) : 0.f;
#pragma unroll
        for (int tok = 0; tok < 16; ++tok) { float s = 0.f;
#pragma unroll
            for (int j = 0; j < 16; ++j) if (j < win) s += arr[15 + tok - j];
            const int cnt = min(tseq0 + tok + 1, win);
            pooled[tok * 512 + tid] = s / (float)cnt - arr[15 + tok]; }
    }
    __syncthreads();
    float aw[16], aa[16], ag[16], ap[16];
#pragma unroll
    for (int t = 0; t < 16; ++t) { aw[t] = 0.f; aa[t] = 0.f; ag[t] = 0.f; ap[t] = 0.f; }
#pragma unroll 1
    for (int i = 0; i < 64; i += 4) { float w[4], a[4];
#pragma unroll
        for (int e = 0; e < 4; ++e) { w[e] = W.w2[(i + e) * 512 + tid]; a[e] = W.a2[(i + e) * 512 + tid]; }
#pragma unroll
        for (int t = 0; t < 16; ++t) { const f32x4 lw = *(const LAS f32x4*)(lora + t * 256 + i), la = *(const LAS f32x4*)(lora + t * 256 + 64 + i);
            aw[t] += lw.x * w[0] + lw.y * w[1] + lw.z * w[2] + lw.w * w[3]; aa[t] += la.x * a[0] + la.y * a[1] + la.z * a[2] + la.w * a[3]; } }
#pragma unroll 1
    for (int i = 0; i < 128; i += 4) { float g[4], pw[4];
#pragma unroll
        for (int e = 0; e < 4; ++e) { g[e] = W.g2[(i + e) * 512 + tid]; pw[e] = W.wpool[(size_t)(grp * 128 + i + e) * 128 + (tid & 127)]; }
#pragma unroll
        for (int t = 0; t < 16; ++t) { const f32x4 lg = *(const LAS f32x4*)(lora + t * 256 + 128 + i), lp = *(const LAS f32x4*)(pooled + t * 512 + grp * 128 + i);
            ag[t] += lg.x * g[0] + lg.y * g[1] + lg.z * g[2] + lg.w * g[3]; ap[t] += lp.x * pw[0] + lp.y * pw[1] + lp.z * pw[2] + lp.w * pw[3]; } }
    const float mu_r = W.mu[tid], mu_k = W.mu[512 + tid], mu_v = W.mu[1024 + tid];
    const float w0c = W.w0[tid], a0c = W.a0[tid], kkc = W.k_k[tid], kac = W.k_a[tid], rkc = W.r_k[tid], bp = W.bpool[tid], ps = W.pscale[tid];
#pragma unroll
    for (int t = 0; t < 16; ++t) { const size_t row = (size_t)(t0g + t); const bool first = (tseq0 + t == 0);
        const bf16* pc = P1 + row * IN1 + tid; const bf16* pp = pc - IN1;
        const float rc = bf2f(pc[0]), kc = bf2f(pc[512]), vc = bf2f(pc[1024]);
        const float rp = first ? 0.f : bf2f(pp[0]), kp_ = first ? 0.f : bf2f(pp[512]), vp = first ? 0.f : bf2f(pp[1024]);
        const float rr = rc + (rp - rc) * mu_r, kk_ = kc + (kp_ - kc) * mu_k, vv = vc + (vp - vc) * mu_v;
        const float wl = w0c + aw[t]; const float logw = -softplusf_(-wl) - 0.5f; const float ee = __expf(logw);
        const float ic = sigmoidf_(a0c + aa[t]);
        const float kkr = kk_ * kkc; const float ss = wave_sum(kkr * kkr); const float kkn = kkr * rsqrtf(fmaxf(ss, 1e-24f));
        const float kpm = kk_ * (1.0f + (ic - 1.0f) * kac);
        const float bon = wave_sum(rr * kpm * rkc);
        const size_t o = row * RWD + tid;
        Ar[o] = (bf16)f2bf(rr); Ae[o] = (bf16)f2bf(1.0f - __expf(-ee)); Ak[o] = (bf16)f2bf(kpm); Av[o] = (bf16)f2bf(vv); Akk[o] = (bf16)f2bf(kkn); Ab[o] = (bf16)f2bf(kkn * ic);
        MIX[row * D + tid] = (bf16)f2bf(ag[t]);
        MIX[row * D + 512 + tid] = (bf16)f2bf((ap[t] + bp) * ps);
        if (lane == 0) BON[row * 8 + wave] = bon; }
    __syncthreads();
}

typedef float f2 __attribute__((ext_vector_type(2)));
__device__ __forceinline__ f2 unpk(unsigned d) { f2 r; r.x = __uint_as_float(d << 16); r.y = __uint_as_float(d & 0xffff0000u); return r; }
#define DPPADD(x, ctrl) x += __int_as_float(__builtin_amdgcn_update_dpp(0, __float_as_int(x), ctrl, 0xF, 0xF, false))
#define DPPGET(x, ctrl) __int_as_float(__builtin_amdgcn_update_dpp(0, __float_as_int(x), ctrl, 0xF, 0xF, false))
#define SWZ(x, pat) __int_as_float(__builtin_amdgcn_ds_swizzle(__float_as_int(x), pat))
__device__ __forceinline__ void scan_unit(const bf16* Ar, const bf16* Au, const bf16* Ak, const bf16* Av, const bf16* Akk, const bf16* Ab, float* Y, int uu, int lane) {
    const int bh = uu >> 5, ip = uu & 31, b = bh >> 3, hd = bh & 7;
    const int hlf = lane >> 5, cp = lane & 31, row = 2 * ip + hlf;
    const size_t base = (size_t)b * SEQ * RWD + hd * 64;
    typedef const __attribute__((address_space(1))) unsigned* gcu; typedef const __attribute__((address_space(1))) bf16* gcb; typedef __attribute__((address_space(1))) float* gf;
    gcu pr = (gcu)(Ar + base) + cp, pu = (gcu)(Au + base) + cp, pk = (gcu)(Ak + base) + cp, pkk = (gcu)(Akk + base) + cp, pb = (gcu)(Ab + base) + cp;
    gcb pv = (gcb)(Av + base + row);
    gf py = (gf)(Y + base + row);
    constexpr int TB = 8, DW = RWD / 2;
    f2 S = {0.f, 0.f};
    unsigned nr[TB], nu[TB], nk[TB], nkk[TB], nb[TB]; bf16 nv[TB];
#pragma unroll
    for (int s = 0; s < TB; ++s) { const size_t o = (size_t)s * DW; nr[s] = pr[o]; nu[s] = pu[o]; nk[s] = pk[o]; nkk[s] = pkk[o]; nb[s] = pb[o]; nv[s] = pv[(size_t)s * RWD]; }
    const bool l1 = lane & 1, l2 = lane & 2, l4 = lane & 4;
#pragma unroll 1
    for (int blk = 0; blk < SEQ / TB; ++blk) {
        unsigned cr[TB], cu[TB], ck[TB], ckk[TB], cb[TB]; float cv[TB];
#pragma unroll
        for (int s = 0; s < TB; ++s) { cr[s] = nr[s]; cu[s] = nu[s]; ck[s] = nk[s]; ckk[s] = nkk[s]; cb[s] = nb[s]; cv[s] = bf2f(nv[s]); }
        if (blk + 1 < SEQ / TB) {
#pragma unroll
            for (int s = 0; s < TB; ++s) { const size_t o = (size_t)((blk + 1) * TB + s) * DW; nr[s] = pr[o]; nu[s] = pu[o]; nk[s] = pk[o]; nkk[s] = pkk[o]; nb[s] = pb[o]; nv[s] = pv[(size_t)((blk + 1) * TB + s) * RWD]; }
        }
        float q[TB];
#pragma unroll
        for (int s = 0; s < TB; ++s) {
            const f2 kk = unpk(ckk[s]);
            const f2 pp = S * kk; float p = pp.x + pp.y;
            DPPADD(p, 0xB1); DPPADD(p, 0x4E); DPPADD(p, 0x141); DPPADD(p, 0x140);
            const auto sw = __builtin_amdgcn_permlane16_swap(__float_as_uint(p), __float_as_uint(p), false, false);
            const float sa = -(__uint_as_float(sw[0]) + __uint_as_float(sw[1]));
            const f2 w = 1.0f - unpk(cu[s]);
            const f2 tmp = unpk(ck[s]) * cv[s] + unpk(cb[s]) * sa;
            S = S * w + tmp;
            const f2 qq = S * unpk(cr[s]); q[s] = qq.x + qq.y;
        }
        float r1[4], r2[2];
#pragma unroll
        for (int m = 0; m < 4; ++m) { const float keep = l1 ? q[2 * m + 1] : q[2 * m], send = l1 ? q[2 * m] : q[2 * m + 1]; r1[m] = keep + DPPGET(send, 0xB1); }
#pragma unroll
        for (int n = 0; n < 2; ++n) { const float keep = l2 ? r1[2 * n + 1] : r1[2 * n], send = l2 ? r1[2 * n] : r1[2 * n + 1]; r2[n] = keep + DPPGET(send, 0x4E); }
        float r3; { const float keep = l4 ? r2[1] : r2[0], send = l4 ? r2[0] : r2[1]; r3 = keep + SWZ(send, 0x101F); }
        r3 += SWZ(r3, 0x201F);
        r3 += SWZ(r3, 0x401F);
        if (cp < 8) py[(size_t)(blk * TB + cp) * RWD] = r3;
    }
}

__device__ __forceinline__ void post_phase(const float* Y, const bf16* Av, const float* BON, bf16* MIX, const float* lg, const float* lb, int bid, int G, int tid, int wave, int lane) {
    const float g = lg[tid], bb = lb[tid];
    for (int m = bid; m < M; m += G) {
        const float y = Y[(size_t)m * RWD + tid];
        const float mean = wave_sum(y) * (1.f / 64.f); const float d = y - mean; const float var = wave_sum(d * d) * (1.f / 64.f);
        const float yn = d * rsqrtf(var + GN_EPS) * g + bb;
        const float o = (yn + BON[(size_t)m * 8 + wave] * bf2f(Av[(size_t)m * RWD + tid])) * bf2f(MIX[(size_t)m * D + tid]);
        MIX[(size_t)m * D + tid] = (bf16)f2bf(o);
    }
}

#ifndef EN0
#define EN0 1
#endif
#ifndef EN1
#define EN1 1
#endif
#ifndef EN2
#define EN2 1
#endif
#ifndef EN3
#define EN3 1
#endif
#ifndef EN4
#define EN4 1
#endif
#ifndef EN5
#define EN5 1
#endif
#ifndef EN7
#define EN7 1
#endif
#ifndef EN8
#define EN8 1
#endif
#ifndef EN9
#define EN9 1
#endif
__global__ void __launch_bounds__(NTHR, 2) mega_fwd(Args args) {
    extern __shared__ __attribute__((aligned(16))) unsigned char lds[];
    LAS unsigned char* L = (LAS unsigned char*)lds;
    LAS float* lf = (LAS float*)lds;
    cg::grid_group grid = cg::this_grid();
    const int tid0 = threadIdx.x;
    const int G = gridDim.x, NGW = G * NWAVES;
    unsigned char* ws0 = args.ws;

    const int ph_lo = args.ph_lo, ph_hi = args.ph_hi;
    volatile LAS unsigned* MISC = (volatile LAS unsigned*)(L + 131072 + 512);
    if (tid0 < 64) MISC[tid0] = 0u;
    __syncthreads();
    if (ph_hi - ph_lo > 1) (void)xcd_barrier_post((unsigned*)ws0, MISC + 8);
    if (ph_lo < 0) grid.sync();
    for (int ph = ph_lo; ph < ph_hi; ++ph) {
        const __attribute__((address_space(4))) Args* ap = (const __attribute__((address_space(4))) Args*)__builtin_amdgcn_kernarg_segment_ptr(); asm volatile("" : "+s"(ap));
        int tid = tid0; asm volatile("" : "+v"(tid));
        int bid = blockIdx.x; asm volatile("" : "+s"(bid));
        unsigned char* ws = ws0; asm volatile("" : "+s"(ws));
        const int lane = tid & 63, wave = __builtin_amdgcn_readfirstlane(tid >> 6), gw = bid * NWAVES + wave;
        if (ph > ph_lo) { XcdBarrier xb; xb.bar = (unsigned*)ws; xb.x = xb_xcc_id(); xb.st = MISC + 8; xcd_barrier(xb); }
        const float* x_in = ap->in[0]; const float* ffn_in = ap->in[1]; const float* ffn_out = ap->in[2]; const float* ln_g = ap->in[3]; const float* ln_b = ap->in[4];
        float* X = ap->out;
        bf16* XN = (bf16*)(ws + WS_XN); bf16* H = (bf16*)(ws + WS_H); bf16* MIX = (bf16*)(ws + WS_MIX);
        bf16* PB = (bf16*)(ws + WS_H);
        float* Y = (float*)(ws + WS_H);
        bf16* Ar = (bf16*)(ws + WS_ARR); bf16* Ae = Ar + (size_t)M * RWD; bf16* Ak = Ae + (size_t)M * RWD; bf16* Av = Ak + (size_t)M * RWD;
        bf16* Akk = (bf16*)(ws + WS_XN); bf16* Ab = Akk + (size_t)M * RWD;
        float* BON = (float*)(ws + WS_BON);
        int kind, par;
        int oph = ph; if (DUP_PH >= 0 && ph > DUP_PH) oph = (ph - DUP_N > DUP_PH) ? ph - DUP_N : DUP_PH;
        switch (oph) {
            case 0: kind = 0; par = 0; break;
            case 1: kind = 1; par = 0; break;  case 2: kind = 2; par = 0; break;  case 3: kind = 3; par = 0; break;
            case 4: kind = 4; par = 0; break;  case 5: kind = 5; par = 0; break;  case 6: kind = 6; par = 0; break;
            case 7: kind = 3; par = 1; break;  case 8: kind = 1; par = 1; break;  case 9: kind = 2; par = 1; break;
            case 10: kind = 3; par = 2; break; case 11: kind = 1; par = 2; break; case 12: kind = 2; par = 2; break;
            case 13: kind = 3; par = 3; break; case 14: kind = 4; par = 1; break; case 15: kind = 7; par = 0; break;
            case 16: kind = 8; par = 0; break; case 17: kind = 9; par = 0; break; case 18: kind = 6; par = 1; break;
            case 19: kind = 3; par = 4; break; case 20: kind = 1; par = 3; break; case 21: kind = 2; par = 3; break;
            default: kind = 3; par = 5; break;
        }
        if (kind == 0 && EN0) {
            LAS float* scr = (LAS float*)(L + wave * 16384);
            constexpr int I_FI = 16 * 176, I_FO = 44 * 32, I_EIN = 16 * 80, I_EO = 16 * 32, I_OIN = 16 * 72, I_OO = 16 * 32;
            constexpr int NIT = 4 * I_FI + 4 * I_FO + I_EIN + I_EO + I_OIN + I_OO;
            for (int it = gw; it < NIT; it += NGW) {
                int r = it;
                if (r < 4 * I_FI) { const int f = r / I_FI; transpose_item(ffn_in + (size_t)f * D * NFF, D, NFF, (bf16*)(ws + WS_WFI + f * WFI_STRIDE), 1, scr, r % I_FI, lane); continue; } r -= 4 * I_FI;
                if (r < 4 * I_FO) { const int f = r / I_FO; transpose_item(ffn_out + (size_t)f * DFF * D, DFF, D, (bf16*)(ws + WS_WFO + f * WFO_STRIDE), 0, scr, r % I_FO, lane); continue; } r -= 4 * I_FO;
                if (r < I_EIN) { transpose_item(ap->in[5], D, IN0, (bf16*)(ws + WS_EIN), 0, scr, r, lane); continue; } r -= I_EIN;
                if (r < I_EO) { transpose_item(ap->in[10], D, D, (bf16*)(ws + WS_EOUT), 0, scr, r, lane); continue; } r -= I_EO;
                if (r < I_OIN) { transpose_item(ap->in[11], D, IN1, (bf16*)(ws + WS_OIN), 0, scr, r, lane); continue; } r -= I_OIN;
                transpose_item(ap->in[26], D, D, (bf16*)(ws + WS_OOUT), 0, scr, r, lane);
            }
            for (size_t i = ((size_t)bid * NTHR + tid) * 8; i < (size_t)M * D; i += (size_t)G * NTHR * 8) {
                const f32x4 a = *(const f32x4*)(x_in + i), c = *(const f32x4*)(x_in + i + 4);
                v4u o; o.x = pk2(a.x, a.y); o.y = pk2(a.z, a.w); o.z = pk2(c.x, c.y); o.w = pk2(c.z, c.w); *(v4u*)(XN + i) = o; }
        } else if (kind == 1 && EN1) {
            pg8::Gemm g{XN, (const bf16*)(ws + WS_WFI + par * WFI_STRIDE), M, NFF, D}; pg8::StaticOrder S; S.init(M, NFF, G, bid);
            pg8::EpiSwiglu E{H, DFF};
            pg8::gemm_phase<pg8::EpiSwiglu, pg8::StaticOrder, true, true>(L, g, S, E);
        } else if ((kind == 2 || kind == 6) && EN2) {
            pg8::Gemm g; pg8::EpiRes E;
            if (kind == 2) { g = pg8::Gemm{H, (const bf16*)(ws + WS_WFO + par * WFO_STRIDE), M, D, DFF}; E = pg8::EpiRes{par == 0 ? x_in : X, X, D, DN_ALPHA, 0.5f}; }
            else { g = pg8::Gemm{MIX, (const bf16*)(ws + (par == 0 ? WS_EOUT : WS_OOUT)), M, D, D}; E = pg8::EpiRes{X, X, D, DN_ALPHA, 1.0f}; }
            pg8::StaticOrder S; S.init(M, D, G, bid);
            pg8::gemm_phase<pg8::EpiRes, pg8::StaticOrder, true, true>(L, g, S, E);
        } else if (kind == 3 && EN3) {
            ln_phase(X, X, XN, ln_g + par * D, ln_b + par * D, par != 5, gw, NGW, lane);
#if PROBE_LN
            if (par == 0) { for (int rep = 0; rep < PROBE_LN; ++rep) { { XcdBarrier xb; xb.bar = (unsigned*)ws; xb.x = xb_xcc_id(); xb.st = MISC + 8; xcd_barrier(xb); } ln_phase(X, (float*)(ws + WS_H), (bf16*)(ws + WS_H + 128 * MiB), ln_g, ln_b, true, gw, NGW, lane); } }
#endif
#if PROBE_SYNC
            if (par == 0) { for (int rep = 0; rep < PROBE_SYNC; ++rep) { XcdBarrier xb; xb.bar = (unsigned*)ws; xb.x = xb_xcc_id(); xb.st = MISC + 8; xcd_barrier(xb); } }
#endif
        } else if (kind == 4 && EN4) {
            const int N = par == 0 ? IN0 : IN1;
            pg8::Gemm g{XN, (const bf16*)(ws + (par == 0 ? WS_EIN : WS_OIN)), M, N, D}; pg8::StaticOrder S; S.init(M, N, G, bid);
            pg8::EpiBf16<0> E{PB, N, nullptr, 0, 0, 1.f};
            pg8::gemm_phase<pg8::EpiBf16<0>, pg8::StaticOrder, true, true>(L, g, S, E);
        } else if (kind == 5 && EN5) {
            for (int u = bid; u < M / 32; u += G) conv_unit(PB, MIX, ap->in[6], ap->in[7], ap->in[8], ap->in[9], lf, u, tid, wave, lane);
            for (int u = gw; u < 4 * 8 * 256; u += NGW) attn_unit(PB, MIX, u, lane);
        } else if (kind == 7 && EN7) {
            OddW W{ap->in[12], ap->in[13], ap->in[14], ap->in[15], ap->in[16], ap->in[17], ap->in[18], ap->in[19], ap->in[20], ap->in[23], ap->in[24], ap->in[25]};
            for (int u = bid; u < M / 16; u += G) prep_unit(PB, W, Ar, Ae, Ak, Av, Akk, Ab, MIX, BON, lf, u, tid, wave, lane);
        } else if (kind == 8 && EN8) {
            if (wave < 4) for (int u = bid * 4 + wave; u < 4 * 8 * 32; u += G * 4) scan_unit(Ar, Ae, Ak, Av, Akk, Ab, Y, u, lane);
        } else if (kind == 9 && EN9) {
            post_phase(Y, Av, BON, MIX, ap->in[21], ap->in[22], bid, G, tid, wave, lane);
        }
    }
}

extern "C" void kernel_launch(void* const* d_in, const int* in_sizes, int n_in, void* d_out, int out_size, void* d_ws, size_t ws_size, hipStream_t stream) {
    static int grid = 0;
    if (grid == 0) {
        if (n_in != 27 || in_sizes[0] != M * D || out_size != M * D || ws_size < WS_END) { fprintf(stderr, "kernel_launch: unexpected shapes (n_in %d, in0 %d, out %d, ws %zu)\n", n_in, n_in > 0 ? in_sizes[0] : -1, out_size, ws_size); grid = -1; return; }
        int dev = 0, cus = 0, per_cu = 0;
        (void)hipGetDevice(&dev); (void)hipDeviceGetAttribute(&cus, hipDeviceAttributeMultiprocessorCount, dev);
        if (hipFuncSetAttribute((const void*)mega_fwd, hipFuncAttributeMaxDynamicSharedMemorySize, LDS_BYTES) != hipSuccess) { fprintf(stderr, "kernel_launch: hipFuncSetAttribute failed\n"); grid = -1; return; }
        if (hipOccupancyMaxActiveBlocksPerMultiprocessor(&per_cu, (const void*)mega_fwd, NTHR, LDS_BYTES) != hipSuccess || per_cu < 1) { fprintf(stderr, "kernel_launch: occupancy query gave %d\n", per_cu); per_cu = 1; }
        (void)hipGetLastError();
        grid = cus * per_cu;
        fprintf(stderr, "kernel_launch: grid %d (cus %d x %d)\n", grid, cus, per_cu);
    }
    if (grid < 0) return;
    Args a{};
    for (int i = 0; i < 27; ++i) a.in[i] = (const float*)d_in[i];
    a.out = (float*)d_out; a.ws = (unsigned char*)d_ws;
#if MK_N_LAUNCHES == 1
    if (hipMemsetAsync(d_ws, 0, 65536, stream) != hipSuccess) { fprintf(stderr, "kernel_launch: memset failed\n"); return; }
    a.ph_lo = 0; a.ph_hi = NPH;
    void* kargs[] = {&a};
    hipError_t e = hipLaunchCooperativeKernel((const void*)mega_fwd, dim3(grid), dim3(NTHR), kargs, LDS_BYTES, stream);
    if (e != hipSuccess) fprintf(stderr, "cooperative launch failed: %s (grid %d)\n", hipGetErrorString(e), grid);
#else
    for (int ph = 0; ph < NPH; ++ph) { a.ph_lo = ph; a.ph_hi = ph + 1; hipLaunchKernelGGL(mega_fwd, dim3(grid), dim3(NTHR), LDS_BYTES, stream, a); }
#endif
}
```
